# Optimizing an MI355X kernel written in HIP

```python
import math
import jax
import jax.numpy as jnp
from jax import lax
import numpy as np

D_MODEL = 1024
BATCH = 8
SEQ = 2048
DEPTH = 2
DEC_BATCH = 32
DEC_SEQ = 16
PAST_LEN = 2048

CHUNK = 64
N_AB_LAYERS = (DEPTH + 1) // 2
N_POOL_LAYERS = DEPTH // 2
EPS = 1e-6
NEG_INF = -1e30

A_HEADS = 8
A_KV_HEADS = 2
A_HEAD_DIM = 64
A_WIDTH = A_HEADS * A_HEAD_DIM
A_KV_WIDTH = A_KV_HEADS * A_HEAD_DIM
WINDOW = 128
WINDOW_CHUNKS = WINDOW // CHUNK

B_HEADS = 4
B_HEAD_DIM = 128
B_WIDTH = B_HEADS * B_HEAD_DIM
CONV_W = 4

POOL_SIZES = (2, 4, 8, 16)
POOL_GROUPS = len(POOL_SIZES)
C_WIDTH = D_MODEL
C_GROUP = C_WIDTH // POOL_GROUPS
POOL_HIST = max(POOL_SIZES) - 1

AB_WIDTHS = (A_WIDTH, A_KV_WIDTH, A_KV_WIDTH, A_WIDTH, 3 * B_WIDTH, B_WIDTH, B_HEADS, B_HEADS)
AB_IN = sum(AB_WIDTHS)

kernel_name = 'hybrid_swa_deltanet_pool_stream_step'


def rms_norm(x, g):
    xf = x.astype(jnp.float32)
    y = xf * lax.rsqrt(jnp.mean(xf * xf, axis=-1, keepdims=True) + EPS)
    return (y * g.astype(jnp.float32)).astype(x.dtype)


def l2_norm(x):
    return x * lax.rsqrt(jnp.sum(x * x, axis=-1, keepdims=True) + EPS)


def split_cols(z, widths):
    out, start = [], 0
    for w in widths:
        out.append(z[..., start:start + w])
        start += w
    return out


def sink_attention(q, k, v, mask, dist, sinks):
    Bn, N, Lq, H, D = q.shape
    G = k.shape[3]
    R = H // G
    qg = q.reshape(Bn, N, Lq, G, R, D)
    s = jnp.einsum('bnqgrd,bnkgd->bngrqk', qg, k, preferred_element_type=jnp.float32) * (D ** -0.5)
    slopes = 2.0 ** (-8.0 * jnp.arange(1, H + 1, dtype=jnp.float32) / H)
    s = s - slopes.reshape(G, R)[:, :, None, None] * dist[:, None, None]
    s = jnp.where(mask[:, None, None], s, NEG_INF)
    sk = sinks.astype(jnp.float32).reshape(G, R)[:, :, None, None]
    m = jnp.maximum(jnp.max(s, axis=-1, keepdims=True), sk)
    p = jnp.exp(s - m)
    w = p / (jnp.sum(p, axis=-1, keepdims=True) + jnp.exp(sk - m))
    o = jnp.einsum('bngrqk,bnkgd->bnqgrd', w.astype(v.dtype), v)
    return o.reshape(Bn, N, Lq, H * D)


def band_blocks(a):
    Bn, T = a.shape[:2]
    nc = T // CHUNK
    ap = jnp.pad(a, ((0, 0), (WINDOW, 0), (0, 0), (0, 0)))
    ap = ap.reshape((Bn, nc + WINDOW_CHUNKS, CHUNK) + a.shape[2:])
    return jnp.concatenate([ap[:, j:j + nc] for j in range(WINDOW_CHUNKS + 1)], axis=2)


def swa_prompt(q, k, v, sinks):
    Bn, T = q.shape[:2]
    nc = T // CHUNK
    lk = (WINDOW_CHUNKS + 1) * CHUNK
    qb = q.reshape(Bn, nc, CHUNK, A_HEADS, A_HEAD_DIM)
    qpos = jnp.arange(T).reshape(nc, CHUNK)
    kpos = (jnp.arange(nc)[:, None] - WINDOW_CHUNKS) * CHUNK + jnp.arange(lk)[None, :]
    mask = jnp.broadcast_to((kpos >= 0)[:, None, :], (nc, CHUNK, lk))
    dist = jnp.abs(qpos[:, :, None] - kpos[:, None, :]).astype(jnp.float32)
    return sink_attention(qb, band_blocks(k), band_blocks(v), mask, dist, sinks)


def swa_sample(q, k, v, cache_k, cache_v, sinks, pos0):
    T = q.shape[1]
    nbuf = cache_k.shape[1]
    kk = jnp.concatenate([cache_k.astype(k.dtype), k], axis=1)[:, None]
    vv = jnp.concatenate([cache_v.astype(v.dtype), v], axis=1)[:, None]
    qpos = pos0 + jnp.arange(T)
    kpos = pos0 - nbuf + jnp.arange(nbuf + T)
    mask = jnp.ones((1, T, nbuf + T), dtype=bool)
    dist = jnp.abs(qpos[:, None] - kpos[None, :]).astype(jnp.float32)[None]
    return sink_attention(q[:, None], kk, vv, mask, dist, sinks)


def causal_conv(u, hist, w):
    T = u.shape[1]
    up = jnp.concatenate([hist.astype(u.dtype), u], axis=1)
    y = up[:, 0:T] * w[0]
    for j in range(1, CONV_W):
        y = y + up[:, j:j + T] * w[j]
    return jax.nn.silu(y), up[:, -(CONV_W - 1):]


def gated_delta_rule(q, k, v, beta, g, s0, chunk):
    Bn, T, H, Dk = q.shape
    Dv = v.shape[-1]
    n = T // chunk

    def blk(a):
        a = a.reshape((Bn, n, chunk, H) + a.shape[3:])
        return jnp.moveaxis(a, 3, 1)

    q, k, v, beta, g = blk(q) * (Dk ** -0.5), blk(k), blk(v), blk(beta), blk(g)
    G = jnp.cumsum(g, axis=-1)
    lower = jnp.tril(jnp.ones((chunk, chunk), dtype=bool))
    strict = jnp.tril(jnp.ones((chunk, chunk), dtype=bool), k=-1)
    diff = G[..., :, None] - G[..., None, :]
    decay = jnp.where(lower, jnp.exp(jnp.where(lower, diff, 0.0)), 0.0)
    kb = k * beta[..., None]
    a_mat = jnp.where(strict, jnp.einsum('bhnid,bhnjd->bhnij', kb, k) * decay, 0.0) + jnp.eye(chunk, dtype=q.dtype)
    rhs = jnp.concatenate([v * beta[..., None], kb * jnp.exp(G)[..., None]], axis=-1)
    sol = lax.linalg.triangular_solve(a_mat, rhs, left_side=True, lower=True, unit_diagonal=True)
    u, w = sol[..., :Dv], sol[..., Dv:]
    qk = jnp.einsum('bhnid,bhnjd->bhnij', q, k) * decay
    q_dec = q * jnp.exp(G)[..., None]
    k_dec = k * jnp.exp(G[..., -1:] - G)[..., None]
    g_tot = jnp.exp(G[..., -1])

    def step(s, xs):
        qk_n, qd_n, kd_n, u_n, w_n, gt_n = xs
        v_new = u_n - jnp.einsum('bhck,bhkv->bhcv', w_n, s)
        o = jnp.einsum('bhck,bhkv->bhcv', qd_n, s) + jnp.einsum('bhij,bhjv->bhiv', qk_n, v_new)
        s = s * gt_n[..., None, None] + jnp.einsum('bhck,bhcv->bhkv', kd_n, v_new)
        return s, o

    xs = tuple(jnp.moveaxis(a, 2, 0) for a in (qk, q_dec, k_dec, u, w, g_tot))
    s_fin, o = lax.scan(step, s0, xs)
    o = jnp.moveaxis(jnp.moveaxis(o, 0, 2), 1, 3).reshape(Bn, T, H, Dv)
    return o, s_fin


def ab_layer(h, norm_g, w_in, q_norm, k_norm, sinks, conv_w, a_log, dt_bias, o_norm, w_out,
             cache_k, cache_v, s0, conv_hist, pos0):
    Bn, T, _ = h.shape
    f32 = jnp.float32
    z = rms_norm(h, norm_g) @ w_in
    a_q, a_k, a_v, a_g, b_qkv, b_g, b_beta, b_alpha = split_cols(z, AB_WIDTHS)
    q = rms_norm(a_q.reshape(Bn, T, A_HEADS, A_HEAD_DIM), q_norm)
    k = rms_norm(a_k.reshape(Bn, T, A_KV_HEADS, A_HEAD_DIM), k_norm)
    v = a_v.reshape(Bn, T, A_KV_HEADS, A_HEAD_DIM)
    if cache_k is None:
        o_a = swa_prompt(q, k, v, sinks)
        new_k, new_v = k[:, -WINDOW:], v[:, -WINDOW:]
        chunk = CHUNK
    else:
        o_a = swa_sample(q, k, v, cache_k, cache_v, sinks, pos0)
        new_k, new_v = k, v
        chunk = T
    o_a = o_a.reshape(Bn, T, A_WIDTH) * jax.nn.silu(a_g)
    c, new_hist = causal_conv(b_qkv, conv_hist, conv_w)
    bq, bk, bv = jnp.split(c, 3, axis=-1)
    bq = l2_norm(bq.reshape(Bn, T, B_HEADS, B_HEAD_DIM).astype(f32))
    bk = l2_norm(bk.reshape(Bn, T, B_HEADS, B_HEAD_DIM).astype(f32))
    bv = bv.reshape(Bn, T, B_HEADS, B_HEAD_DIM).astype(f32)
    beta = jax.nn.sigmoid(b_beta.astype(f32))
    g = -jnp.exp(a_log.astype(f32)) * jax.nn.softplus(b_alpha.astype(f32) + dt_bias.astype(f32))
    o_b, s_new = gated_delta_rule(bq, bk, bv, beta, g, s0.astype(f32), chunk)
    o_b = rms_norm(o_b, o_norm).astype(h.dtype).reshape(Bn, T, B_WIDTH) * jax.nn.silu(b_g)
    y = h + jnp.concatenate([o_a, o_b], axis=-1) @ w_out
    return y, (new_k, new_v, s_new.astype(h.dtype), new_hist)


def pool_layer(h, norm_g, w_in, w_grp, scale, w_out, hist, pos0):
    Bn, T, _ = h.shape
    f32 = jnp.float32
    z = rms_norm(h, norm_g) @ w_in
    u, gate = z[..., :C_WIDTH], z[..., C_WIDTH:]
    ue = jnp.concatenate([hist.astype(u.dtype), u], axis=1)
    pos = pos0 - POOL_HIST + jnp.arange(POOL_HIST + T)
    uf = ue.astype(f32) * (pos >= 0)[None, :, None]
    cs = jnp.concatenate([jnp.zeros((Bn, 1, C_WIDTH), f32), jnp.cumsum(uf, axis=1)], axis=1)
    hi = cs[:, POOL_HIST + 1:]
    means = []
    for gi, w in enumerate(POOL_SIZES):
        cols = slice(gi * C_GROUP, (gi + 1) * C_GROUP)
        lo = cs[:, POOL_HIST + 1 - w:POOL_HIST + 1 - w + T, cols]
        cnt = jnp.minimum(pos[POOL_HIST:] + 1, w).astype(f32)
        means.append((hi[..., cols] - lo) / cnt[None, :, None])
    pooled = jnp.concatenate(means, axis=-1) - u.astype(f32)
    mixed = jnp.einsum('btgc,gcd->btgd', pooled.reshape(Bn, T, POOL_GROUPS, C_GROUP), w_grp.astype(f32))
    mixed = (mixed.reshape(Bn, T, C_WIDTH) * scale.astype(f32)).astype(h.dtype)
    y = h + (mixed * jax.nn.silu(gate)) @ w_out
    return y, ue[:, -POOL_HIST:]


def setup_inputs(seed: int = 0) -> dict:
    key = jax.random.key(seed)
    ks = jax.random.split(key, 24)
    f32 = jnp.float32
    na, npl = N_AB_LAYERS, N_POOL_LAYERS

    def nrm(k, shape, s):
        return jax.random.normal(k, shape, f32) * s

    dt = jnp.exp(jax.random.uniform(ks[12], (na, B_HEADS), f32, math.log(1e-3), math.log(1e-1)))
    dt_bias = dt + jnp.log(-jnp.expm1(-dt))
    return {
        'x_prompt': nrm(ks[0], (BATCH, SEQ, D_MODEL), 1.0),
        'x_sample': nrm(ks[1], (DEC_BATCH, DEC_SEQ, D_MODEL), 1.0),
        'cache_a_k': nrm(ks[2], (na, DEC_BATCH, WINDOW, A_KV_HEADS, A_HEAD_DIM), 1.0),
        'cache_a_v': nrm(ks[3], (na, DEC_BATCH, WINDOW, A_KV_HEADS, A_HEAD_DIM), 1.0),
        'state_b_s': nrm(ks[4], (na, DEC_BATCH, B_HEADS, B_HEAD_DIM, B_HEAD_DIM), 0.1),
        'state_b_conv': nrm(ks[5], (na, DEC_BATCH, CONV_W - 1, 3 * B_WIDTH), 1.0),
        'state_c_pool': nrm(ks[6], (npl, DEC_BATCH, POOL_HIST, C_WIDTH), 1.0),
        'norm_ab': 1.0 + nrm(ks[7], (na, D_MODEL), 0.02),
        'w_in_ab': nrm(ks[8], (na, D_MODEL, AB_IN), D_MODEL ** -0.5),
        'q_norm_a': 1.0 + nrm(ks[9], (na, A_HEAD_DIM), 0.02),
        'k_norm_a': 1.0 + nrm(ks[10], (na, A_HEAD_DIM), 0.02),
        'sinks_a': nrm(ks[11], (na, A_HEADS), 0.5),
        'conv_b': nrm(ks[13], (na, CONV_W, 3 * B_WIDTH), CONV_W ** -0.5),
        'a_log_b': jnp.log(jax.random.uniform(ks[14], (na, B_HEADS), f32, 1.0, 16.0)),
        'dt_bias_b': dt_bias,
        'o_norm_b': 1.0 + nrm(ks[15], (na, B_HEAD_DIM), 0.02),
        'w_out_ab': nrm(ks[16], (na, A_WIDTH + B_WIDTH, D_MODEL), (A_WIDTH + B_WIDTH) ** -0.5),
        'norm_c': 1.0 + nrm(ks[17], (npl, D_MODEL), 0.02),
        'w_in_c': nrm(ks[18], (npl, D_MODEL, 2 * C_WIDTH), D_MODEL ** -0.5),
        'w_grp_c': nrm(ks[19], (npl, POOL_GROUPS, C_GROUP, C_GROUP), C_GROUP ** -0.5),
        'scale_c': 1.0 + nrm(ks[20], (npl, C_WIDTH), 0.1),
        'w_out_c': nrm(ks[21], (npl, C_WIDTH, D_MODEL), C_WIDTH ** -0.5),
    }


def reference(x_prompt, x_sample, cache_a_k, cache_a_v, state_b_s, state_b_conv, state_c_pool,
              norm_ab, w_in_ab, q_norm_a, k_norm_a, sinks_a, conv_b, a_log_b, dt_bias_b, o_norm_b, w_out_ab,
              norm_c, w_in_c, w_grp_c, scale_c, w_out_c):
    hp, hs = x_prompt, x_sample
    bp = x_prompt.shape[0]
    pa_k, pa_v, pb_s, pb_c, pc = [], [], [], [], []
    sa_k, sa_v, sb_s, sb_c, sc = [], [], [], [], []
    for layer in range(DEPTH):
        i = layer // 2
        if layer % 2 == 0:
            wts = (norm_ab[i], w_in_ab[i], q_norm_a[i], k_norm_a[i], sinks_a[i], conv_b[i],
                   a_log_b[i], dt_bias_b[i], o_norm_b[i], w_out_ab[i])
            s0 = jnp.zeros((bp, B_HEADS, B_HEAD_DIM, B_HEAD_DIM), jnp.float32)
            c0 = jnp.zeros((bp, CONV_W - 1, 3 * B_WIDTH), hp.dtype)
            hp, (k_, v_, s_, c_) = ab_layer(hp, *wts, None, None, s0, c0, 0)
            pa_k.append(k_)
            pa_v.append(v_)
            pb_s.append(s_)
            pb_c.append(c_)
            hs, (k_, v_, s_, c_) = ab_layer(hs, *wts, cache_a_k[i], cache_a_v[i], state_b_s[i],
                                            state_b_conv[i], PAST_LEN)
            sa_k.append(k_)
            sa_v.append(v_)
            sb_s.append(s_)
            sb_c.append(c_)
        else:
            wts = (norm_c[i], w_in_c[i], w_grp_c[i], scale_c[i], w_out_c[i])
            h0 = jnp.zeros((bp, POOL_HIST, C_WIDTH), hp.dtype)
            hp, st = pool_layer(hp, *wts, h0, 0)
            pc.append(st)
            hs, st = pool_layer(hs, *wts, state_c_pool[i], PAST_LEN)
            sc.append(st)
    return (hp, hs,
            jnp.stack(pa_k), jnp.stack(pa_v), jnp.stack(pb_s), jnp.stack(pb_c), jnp.stack(pc),
            jnp.stack(sa_k), jnp.stack(sa_v), jnp.stack(sb_s), jnp.stack(sb_c), jnp.stack(sc))
```

```cpp
#include <hip/hip_runtime.h>
#include <hip/hip_cooperative_groups.h>
#include <cstdio>
namespace cg = cooperative_groups;

#ifndef MK_LAUNCHES
#define MK_LAUNCHES 1
#ifndef MK_STOP
#define MK_STOP 11
#endif
#endif

#define LAS __attribute__((address_space(3)))
typedef unsigned short bf16_t;
typedef short bf16x8 __attribute__((ext_vector_type(8)));
typedef short bf16x4 __attribute__((ext_vector_type(4)));
typedef float f32x4 __attribute__((ext_vector_type(4)));
typedef unsigned u32x4 __attribute__((ext_vector_type(4)));
typedef unsigned u32x2 __attribute__((ext_vector_type(2)));

constexpr int MP = 16384, MS = 512, MTOK = 16896, DM = 1024;
constexpr int NZ = 3328, LDWIN = 3336;
constexpr int ZC_AQ = 0, ZC_AK = 512, ZC_AV = 640, ZC_AG = 768, ZC_BQKV = 1280, ZC_BG = 2816;
constexpr int NCH = 1152;

constexpr size_t WS_WT_IN = 0, WS_WT_OUT = 6815744, WS_WT_INC = 8912896, WS_WT_GRP = 13107200, WS_WT_OUTC = 13631488,
                 WS_XN = 15728640, WS_Z = 50331648, WS_CAT = 162791424, WS_BA = 197394432, WS_SSQ = 197935104, WS_BAR = 200097792, WS_ROWSS = 200097792 + 16384, WS_END = 200181760 + 18874368 + 294912;
constexpr size_t WS_UT = 200181760, WS_GB = WS_UT + 18874368;
constexpr size_t WS_U = WS_Z, WS_SG = WS_Z + 69206016;
constexpr size_t WS_POOL = WS_Z + 34603008, WS_MM = WS_CAT;
constexpr size_t DN_W = 0, DN_QS = 18874368, DN_KT = 37748736, DN_QK = 56623104;

constexpr size_t O_Y = 0, O_PAK = 17301504, O_PAV = 17432576, O_PBS = 17563648, O_PBC = 18087936, O_PCP = 18124800,
                 O_SAK = 18247680, O_SAV = 18313216, O_SBS = 18378752, O_SBC = 20475904, O_SCP = 20623360;

struct Params {
    const float* in[22];
    float* out;
    unsigned char* ws;
    int ph_lo, ph_hi;
};

typedef __bf16 bf16v2_t __attribute__((ext_vector_type(2)));
typedef float f32v2_t __attribute__((ext_vector_type(2)));
__device__ __forceinline__ unsigned cvt_pk_bf16(float lo, float hi) { const f32v2_t v = {lo, hi}; const bf16v2_t r = __builtin_convertvector(v, bf16v2_t); return __builtin_bit_cast(unsigned, r); }
__device__ __forceinline__ bf16_t f2bf(float f) { return (bf16_t)(cvt_pk_bf16(f, 0.f) & 0xffffu); }
__device__ __forceinline__ float bf2f(short b) { return __uint_as_float(((unsigned)(unsigned short)b) << 16); }
__device__ __forceinline__ float silu_f(float x) { return x * __builtin_amdgcn_rcpf(1.0f + __expf(-x)); }
__device__ __forceinline__ bf16x8 pack8(const f32x4& a, const f32x4& b) {
    u32x4 w; w.x = cvt_pk_bf16(a[0], a[1]); w.y = cvt_pk_bf16(a[2], a[3]); w.z = cvt_pk_bf16(b[0], b[1]); w.w = cvt_pk_bf16(b[2], b[3]);
    return __builtin_bit_cast(bf16x8, w);
}
__device__ __forceinline__ bf16x8 cat8(const u32x2& a, const u32x2& b) { u32x4 w; w.x = a.x; w.y = a.y; w.z = b.x; w.w = b.y; return __builtin_bit_cast(bf16x8, w); }
__device__ __forceinline__ f32x4 mfma16(const bf16x8& a, const bf16x8& b, const f32x4& c) { return __builtin_amdgcn_mfma_f32_16x16x32_bf16(a, b, c, 0, 0, 0); }
template <int CTRL> __device__ __forceinline__ float dpp_f(float v) { return __builtin_bit_cast(float, __builtin_amdgcn_update_dpp(0, __builtin_bit_cast(int, v), CTRL, 0xF, 0xF, true)); }
__device__ __forceinline__ float sum8(float v) { v += dpp_f<0xB1>(v); v += dpp_f<0x4E>(v); v += dpp_f<0x141>(v); return v; }
__device__ __forceinline__ float sum16(float v) { v = sum8(v); v += dpp_f<0x140>(v); return v; }
__device__ __forceinline__ float wave_sum(float v) {
    v = sum16(v); v += __shfl_xor(v, 16); v += __shfl_xor(v, 32);
    return v;
}
__device__ __forceinline__ void lds_barrier() { asm volatile("s_waitcnt lgkmcnt(0)" ::: "memory"); __builtin_amdgcn_s_barrier(); asm volatile("" ::: "memory"); }
__device__ __forceinline__ int pos32(int x) { return ((x & 12) << 1) | ((x & 16) >> 2) | (x & 3); }

namespace pg8 {
constexpr int BM = 256, BK = 64, HALF = 128, HTB = HALF * BK * 2, STAGE_BYTES = 8 * HTB, NXCD = 8, WGM = 8;
__device__ __forceinline__ int lds_byte(int r, int c) { const int st = (r >> 4) * 2 + (c >> 5), rr = r & 15, cc = c & 31, ob = rr * 64 + cc * 2; return st * 1024 + (ob ^ (((ob >> 9) & 1) << 5)); }
__device__ __forceinline__ void stage_rc(int b, int& R, int& C) { const int st = b / 1024, sb = b % 1024, swz = sb ^ (((sb >> 9) & 1) << 5); R = (st >> 1) * 16 + swz / 64; C = (st & 1) * 32 + (swz % 64) / 2; }
__device__ __forceinline__ int perm32(int rho) { const int n = rho >> 4, i = rho & 15; return 8 * (i >> 2) + 4 * n + (i & 3); }
struct Unit { int pm, pn; };
struct Gemm { const bf16_t* A; const bf16_t* Bt; int M, N, K, lda, a_pn_step; };
struct StaticOrder {
    int nM, nN, nwg, G, c;
    __device__ void init(int M, int N, int G_, int c_) { nM = M / BM; nN = N / BM; nwg = nM * nN; G = G_; c = c_; }
    __device__ bool next(int i, Unit& u) const {
        const long L = (long)i * G + c; if (L >= nwg) return false;
        int wgid = (int)L; { const int q = nwg / NXCD, r = nwg % NXCD, xcd = wgid % NXCD, off = wgid / NXCD; wgid = (xcd < r ? xcd * (q + 1) : r * (q + 1) + (xcd - r) * q) + off; }
        const int nig = WGM * nN, gid = wgid / nig, fm = gid * WGM, gsz = (nM - fm) < WGM ? (nM - fm) : WGM;
        u.pm = fm + ((wgid % nig) % gsz); u.pn = (wgid % nig) / gsz; return true;
    }
};

template <class Epi>
__device__ __forceinline__ void gemm_phase(LAS unsigned char* lds, const Gemm g, const StaticOrder& S, const Epi& E) {
    const int tid = threadIdx.x, wid = __builtin_amdgcn_readfirstlane(tid >> 6), lane = tid & 63, wr = wid >> 2, wc = wid & 3, fr = lane & 15, fq = lane >> 4;
    const int K = g.K, nt = K / BK;
    unsigned voffA[2], voffB[2];
#pragma unroll
    for (int i = 0; i < 2; ++i) { int R, C; stage_rc(tid * 16 + i * 8192, R, C); const int Rb = Epi::PERM ? ((R & ~31) + perm32(R & 31)) : R;
        voffA[i] = (unsigned)(R * g.lda + C) * 2u; voffB[i] = (unsigned)(Rb * K + C) * 2u; }
    const size_t kstep = (size_t)(BK * 2);
    const size_t hstepA = (size_t)HALF * g.lda * 2, hstepB = (size_t)HALF * K * 2;
    const size_t tstepA = 2 * hstepA, tstepB = 2 * hstepB;
    const unsigned ldsw = (unsigned)wid * 1024u;
    const int aoff = lds_byte(wr * 64 + fr, fq * 8), boff = lds_byte(wc * 32 + fr, fq * 8);
#define PG8_SA(b, h) (((b) * 2 + (h)) * HTB)
#define PG8_SB(b, h) ((4 + (b) * 2 + (h)) * HTB)
#define PG8_STAGE(bufoff, gbase, voff) do { _Pragma("unroll") for (int _i = 0; _i < 2; ++_i) \
        __builtin_amdgcn_global_load_lds((const unsigned*)((const char*)(gbase) + (voff)[_i]), (LAS unsigned*)(lds + (bufoff) + ldsw + _i * 8192), 16, 0, 0); } while (0)
#define PG8_LDA(dst, b, h) do { _Pragma("unroll") for (int m = 0; m < 4; ++m) _Pragma("unroll") for (int k = 0; k < 2; ++k) dst[m][k] = *(const LAS bf16x8*)(lds + PG8_SA(b, h) + aoff + m * 2048 + k * 1024); } while (0)
#define PG8_LDB(dst, b, h) do { _Pragma("unroll") for (int n = 0; n < 2; ++n) _Pragma("unroll") for (int k = 0; k < 2; ++k) dst[n][k] = *(const LAS bf16x8*)(lds + PG8_SB(b, h) + boff + n * 2048 + k * 1024); } while (0)
#define PG8_MMA(ai, bj, At, Bt) do { __builtin_amdgcn_s_setprio(1); _Pragma("unroll") for (int m = 0; m < 4; ++m) _Pragma("unroll") for (int n = 0; n < 2; ++n) _Pragma("unroll") for (int k = 0; k < 2; ++k) \
        acc[ai][bj][m][n] = __builtin_amdgcn_mfma_f32_16x16x32_bf16(Bt[n][k], At[m][k], acc[ai][bj][m][n], 0, 0, 0); __builtin_amdgcn_s_setprio(0); } while (0)
#define PG8_WAIT_V(n) asm volatile("s_waitcnt vmcnt(" #n ")" ::: "memory")
#define PG8_WAIT_L(n) asm volatile("s_waitcnt lgkmcnt(" #n ")" ::: "memory")
#define PG8_BAR __builtin_amdgcn_s_barrier()
#define PG8_SCHED __builtin_amdgcn_sched_barrier(0)
    Unit cur, nxt; int ui = 0;
    if (!S.next(0, cur)) return;
    f32x4 acc[2][2][4][2];
#pragma unroll
    for (int a = 0; a < 2; ++a)
#pragma unroll
        for (int b = 0; b < 2; ++b)
#pragma unroll
            for (int m = 0; m < 4; ++m)
#pragma unroll
                for (int n = 0; n < 2; ++n) acc[a][b][m][n] = (f32x4){0.f, 0.f, 0.f, 0.f};
    bf16x8 At[4][2], B0[2][2], B1[2][2];
    const char* cA = (const char*)g.A + (size_t)cur.pm * tstepA + (size_t)cur.pn * g.a_pn_step; const char* cB = (const char*)g.Bt + (size_t)cur.pn * tstepB;
    PG8_STAGE(PG8_SB(0, 0), cB, voffB); PG8_STAGE(PG8_SA(0, 0), cA, voffA); PG8_STAGE(PG8_SB(0, 1), cB + hstepB, voffB); PG8_STAGE(PG8_SA(0, 1), cA + hstepA, voffA);
    if (wr == 1) PG8_BAR;
    PG8_WAIT_V(4); PG8_BAR;
    PG8_STAGE(PG8_SB(1, 0), cB + kstep, voffB); PG8_STAGE(PG8_SA(1, 0), cA + kstep, voffA); PG8_STAGE(PG8_SB(1, 1), cB + hstepB + kstep, voffB);
    PG8_WAIT_V(6); PG8_BAR;
    for (;;) {
        const bool has_next = S.next(ui + 1, nxt);
        const char* nA = has_next ? (const char*)g.A + (size_t)nxt.pm * tstepA + (size_t)nxt.pn * g.a_pn_step : cA; const char* nB = has_next ? (const char*)g.Bt + (size_t)nxt.pn * tstepB : cB;
#pragma unroll 1
        for (int t = 0; t < nt; t += 2) {
            const bool last = (t == nt - 2);
            const char* a1 = cA + (size_t)(t + 1) * kstep;
            const char* a2 = last ? nA : cA + (size_t)(t + 2) * kstep; const char* b2 = last ? nB : cB + (size_t)(t + 2) * kstep;
            const char* a3 = a2 + kstep; const char* b3 = b2 + kstep;
            PG8_LDB(B0, 0, 0); PG8_SCHED; PG8_LDA(At, 0, 0); PG8_STAGE(PG8_SA(1, 1), a1 + hstepA, voffA);
            PG8_WAIT_L(8); PG8_BAR; PG8_WAIT_L(0); PG8_MMA(0, 0, At, B0); PG8_BAR; PG8_SCHED;
            PG8_LDB(B1, 0, 1); PG8_STAGE(PG8_SB(0, 0), b2, voffB);
            PG8_BAR; PG8_WAIT_L(0); PG8_MMA(0, 1, At, B1); PG8_BAR;
            PG8_LDA(At, 0, 1); PG8_STAGE(PG8_SA(0, 0), a2, voffA);
            PG8_BAR; PG8_WAIT_L(0); PG8_MMA(1, 0, At, B0); PG8_BAR; PG8_SCHED;
            PG8_STAGE(PG8_SB(0, 1), b2 + hstepB, voffB);
            PG8_WAIT_V(6); PG8_BAR; PG8_MMA(1, 1, At, B1); PG8_BAR;
            PG8_LDB(B0, 1, 0); PG8_SCHED; PG8_LDA(At, 1, 0); PG8_STAGE(PG8_SA(0, 1), a2 + hstepA, voffA);
            PG8_WAIT_L(8); PG8_BAR; PG8_WAIT_L(0); PG8_MMA(0, 0, At, B0); PG8_BAR; PG8_SCHED;
            PG8_LDB(B1, 1, 1); PG8_STAGE(PG8_SB(1, 0), b3, voffB);
            PG8_BAR; PG8_WAIT_L(0); PG8_MMA(0, 1, At, B1); PG8_BAR;
            PG8_LDA(At, 1, 1); PG8_STAGE(PG8_SA(1, 0), a3, voffA);
            PG8_BAR; PG8_WAIT_L(0); PG8_MMA(1, 0, At, B0); PG8_BAR; PG8_SCHED;
            PG8_STAGE(PG8_SB(1, 1), b3 + hstepB, voffB);
            PG8_WAIT_V(6); PG8_BAR; PG8_MMA(1, 1, At, B1); PG8_BAR;
        }
        E(acc, cur, wr, wc, fr, fq);
        if (!has_next) break;
#pragma unroll
        for (int a = 0; a < 2; ++a)
#pragma unroll
            for (int b = 0; b < 2; ++b)
#pragma unroll
                for (int m = 0; m < 4; ++m)
#pragma unroll
                    for (int n = 0; n < 2; ++n) acc[a][b][m][n] = (f32x4){0.f, 0.f, 0.f, 0.f};
        cur = nxt; cA = nA; cB = nB; ++ui;
    }
    PG8_WAIT_V(0);
    if (wr == 0) PG8_BAR;
    PG8_BAR;
#undef PG8_SA
#undef PG8_SB
#undef PG8_STAGE
#undef PG8_LDA
#undef PG8_LDB
#undef PG8_MMA
#undef PG8_WAIT_V
#undef PG8_WAIT_L
#undef PG8_BAR
#undef PG8_SCHED
}

struct EpiZ {
    static constexpr bool PERM = true;
    bf16_t* O; int ldc;
    __device__ __forceinline__ void operator()(const f32x4 (&acc)[2][2][4][2], const Unit& u, int wr, int wc, int fr, int fq) const {
        const int row0 = u.pm * BM + wr * 64 + fr, col0 = u.pn * BM + wc * 32 + 8 * fq;
#pragma unroll
        for (int ai = 0; ai < 2; ++ai)
#pragma unroll
            for (int m = 0; m < 4; ++m) { bf16_t* rowp = O + (size_t)(row0 + ai * HALF + m * 16) * ldc + col0;
#pragma unroll
                for (int bj = 0; bj < 2; ++bj) { const f32x4 v0 = acc[ai][bj][m][0], v1 = acc[ai][bj][m][1];
                    u32x4 w; w.x = cvt_pk_bf16(v0[0], v0[1]); w.y = cvt_pk_bf16(v0[2], v0[3]); w.z = cvt_pk_bf16(v1[0], v1[1]); w.w = cvt_pk_bf16(v1[2], v1[3]);
                    *(u32x4*)(rowp + bj * HALF) = w; } }
    }
};
template <bool NORM> struct EpiRes {
    static constexpr bool PERM = false;
    const float* base0; const float* base1; float* out; bf16_t* a3; const float* gvec; float* rowss;
    __device__ __forceinline__ void operator()(const f32x4 (&acc)[2][2][4][2], const Unit& u, int wr, int wc, int fr, int fq) const {
        const int row0 = u.pm * BM + wr * 64 + fr, col0 = u.pn * BM + wc * 32 + 4 * fq;
        const float* bb = (u.pm < 64) ? base0 : base1 - (size_t)MP * DM;
#pragma unroll
        for (int ai = 0; ai < 2; ++ai)
#pragma unroll
            for (int m = 0; m < 4; ++m) { const size_t ro = (size_t)(row0 + ai * HALF + m * 16) * DM + col0; float ss = 0.f;
#pragma unroll
                for (int bj = 0; bj < 2; ++bj)
#pragma unroll
                    for (int n = 0; n < 2; ++n) {
                        if constexpr (NORM) {
                            const f32x4 bv = *(const f32x4*)(bb + ro + bj * HALF + n * 16); const f32x4 v = acc[ai][bj][m][n] + bv;
                            ss += (v[0] * v[0] + v[1] * v[1]) + (v[2] * v[2] + v[3] * v[3]);
                            u32x2 w; w.x = cvt_pk_bf16(v[0], v[1]); w.y = cvt_pk_bf16(v[2], v[3]); *(u32x2*)(a3 + ro + bj * HALF + n * 16) = w;
                        } else {
                            const bf16x4 hb = *(const bf16x4*)(a3 + ro + bj * HALF + n * 16);
                            *(f32x4*)(out + ro + bj * HALF + n * 16) = acc[ai][bj][m][n] + (f32x4){bf2f(hb[0]), bf2f(hb[1]), bf2f(hb[2]), bf2f(hb[3])}; } }
                if constexpr (NORM) { ss += __shfl_xor(ss, 16); ss += __shfl_xor(ss, 32); if (fq == 0) atomicAdd(rowss + row0 + ai * HALF + m * 16, ss); } }
    }
};
struct EpiUG {
    static constexpr bool PERM = true;
    bf16_t* U; bf16_t* SG; const float* rowss;
    __device__ __forceinline__ void operator()(const f32x4 (&acc)[2][2][4][2], const Unit& u, int wr, int wc, int fr, int fq) const {
        const int row0 = u.pm * BM + wr * 64 + fr, col0 = (u.pn & 3) * BM + wc * 32 + 8 * fq;
        const bool isu = u.pn < 4;
#pragma unroll
        for (int ai = 0; ai < 2; ++ai)
#pragma unroll
            for (int m = 0; m < 4; ++m) { const size_t ro = (size_t)(row0 + ai * HALF + m * 16) * DM + col0;
                const float rr = rsqrtf(rowss[row0 + ai * HALF + m * 16] * (1.0f / 1024.0f) + 1e-6f);
#pragma unroll
                for (int bj = 0; bj < 2; ++bj) { const f32x4 v0 = acc[ai][bj][m][0] * rr, v1 = acc[ai][bj][m][1] * rr;
                    if (isu) { u32x4 w; w.x = cvt_pk_bf16(v0[0], v0[1]); w.y = cvt_pk_bf16(v0[2], v0[3]); w.z = cvt_pk_bf16(v1[0], v1[1]); w.w = cvt_pk_bf16(v1[2], v1[3]); *(u32x4*)(U + ro + bj * HALF) = w; }
                    else { u32x4 w; w.x = cvt_pk_bf16(silu_f(v0[0]), silu_f(v0[1])); w.y = cvt_pk_bf16(silu_f(v0[2]), silu_f(v0[3]));
                           w.z = cvt_pk_bf16(silu_f(v1[0]), silu_f(v1[1])); w.w = cvt_pk_bf16(silu_f(v1[2]), silu_f(v1[3]));
                           *(u32x4*)(SG + ro + bj * HALF) = w; } } }
    }
};
struct EpiM {
    static constexpr bool PERM = true;
    const float* scale; const bf16_t* SG; bf16_t* O;
    __device__ __forceinline__ void operator()(const f32x4 (&acc)[2][2][4][2], const Unit& u, int wr, int wc, int fr, int fq) const {
        const int row0 = u.pm * BM + wr * 64 + fr, col0 = u.pn * BM + wc * 32 + 8 * fq;
#pragma unroll
        for (int ai = 0; ai < 2; ++ai)
#pragma unroll
            for (int m = 0; m < 4; ++m) { const size_t ro = (size_t)(row0 + ai * HALF + m * 16) * DM + col0;
#pragma unroll
                for (int bj = 0; bj < 2; ++bj) { const bf16x8 gv = *(const bf16x8*)(SG + ro + bj * HALF);
                    const f32x4 v0 = acc[ai][bj][m][0] * *(const f32x4*)(scale + col0 + bj * HALF), v1 = acc[ai][bj][m][1] * *(const f32x4*)(scale + col0 + bj * HALF + 4);
                    u32x4 w; w.x = cvt_pk_bf16(v0[0] * bf2f(gv[0]), v0[1] * bf2f(gv[1])); w.y = cvt_pk_bf16(v0[2] * bf2f(gv[2]), v0[3] * bf2f(gv[3]));
                    w.z = cvt_pk_bf16(v1[0] * bf2f(gv[4]), v1[1] * bf2f(gv[5])); w.w = cvt_pk_bf16(v1[2] * bf2f(gv[6]), v1[3] * bf2f(gv[7]));
                    *(u32x4*)(O + ro + bj * HALF) = w; } }
    }
};
}

__device__ __forceinline__ void transpose_tile(const float* __restrict__ src, int ld, bf16_t* __restrict__ dst, int K, int k0, int n0, LAS float* tile, const float* __restrict__ kscale) {
    const int tid = threadIdx.x;
#pragma unroll
    for (int i = 0; i < 2; ++i) {
        const int k = (tid >> 4) + 32 * i, n4 = (tid & 15) * 4;
        const float4 v = *(const float4*)(src + (size_t)(k0 + k) * ld + n0 + n4);
        const float ks = kscale ? kscale[k0 + k] : 1.0f;
        LAS float* tp = tile + k * 65 + n4; tp[0] = v.x * ks; tp[1] = v.y * ks; tp[2] = v.z * ks; tp[3] = v.w * ks;
    }
    __syncthreads();
    const int n = tid >> 3, k8 = (tid & 7) * 8;
    float f[8];
#pragma unroll
    for (int j = 0; j < 8; ++j) f[j] = tile[(k8 + j) * 65 + n];
    u32x4 w; w.x = cvt_pk_bf16(f[0], f[1]); w.y = cvt_pk_bf16(f[2], f[3]); w.z = cvt_pk_bf16(f[4], f[5]); w.w = cvt_pk_bf16(f[6], f[7]);
    *(u32x4*)(dst + (size_t)(n0 + n) * K + k0 + k8) = w;
    __syncthreads();
}

template <bool EXTRA>
__device__ __forceinline__ void rmsnorm_rows(const float* __restrict__ x0, const float* __restrict__ x1, const float* __restrict__ g,
                                             const float* __restrict__ wex, bf16_t* __restrict__ xn, float* __restrict__ ba, LAS f32x4* slab) {
    const int lane = threadIdx.x & 63, wid = threadIdx.x >> 6;
    const int gw = blockIdx.x * 8 + wid, nw = gridDim.x * 8;
    float4 gg[4];
#pragma unroll
    for (int i = 0; i < 4; ++i) gg[i] = *(const float4*)(g + lane * 4 + 256 * i);
    if constexpr (EXTRA) {
        for (int idx = threadIdx.x; idx < 2048; idx += 512) { const int k = idx >> 1, half = idx & 1, ln = (k & 255) >> 2, i = k >> 8, e = k & 3;
            slab[((i * 4 + e) * 2 + half) * 64 + ln] = *(const f32x4*)(wex + (size_t)k * LDWIN + half * 4); }
        __syncthreads();
    }
    float4 vn_[4];
    if (gw < MTOK) { const float* x = gw < MP ? x0 + (size_t)gw * DM : x1 + (size_t)(gw - MP) * DM;
#pragma unroll
        for (int i = 0; i < 4; ++i) vn_[i] = *(const float4*)(x + lane * 4 + 256 * i); }
    for (int row = gw; row < MTOK; row += nw) {
        float4 v[4]; float ss = 0.f;
#pragma unroll
        for (int i = 0; i < 4; ++i) v[i] = vn_[i];
        { const int rn = (row + nw < MTOK) ? row + nw : row;
          const float* xn_ = rn < MP ? x0 + (size_t)rn * DM : x1 + (size_t)(rn - MP) * DM;
#pragma unroll
          for (int i = 0; i < 4; ++i) vn_[i] = *(const float4*)(xn_ + lane * 4 + 256 * i); }
#pragma unroll
        for (int i = 0; i < 4; ++i) ss += v[i].x * v[i].x + v[i].y * v[i].y + v[i].z * v[i].z + v[i].w * v[i].w;
        ss = wave_sum(ss);
        const float r = rsqrtf(ss * (1.0f / 1024.0f) + 1e-6f);
        float a[8] = {0.f, 0.f, 0.f, 0.f, 0.f, 0.f, 0.f, 0.f};
#pragma unroll
        for (int i = 0; i < 4; ++i) {
            float y[4] = {v[i].x * r * gg[i].x, v[i].y * r * gg[i].y, v[i].z * r * gg[i].z, v[i].w * r * gg[i].w};
            u32x2 w; w.x = cvt_pk_bf16(y[0], y[1]); w.y = cvt_pk_bf16(y[2], y[3]);
            *(u32x2*)(xn + (size_t)row * DM + lane * 4 + 256 * i) = w;
            if constexpr (EXTRA) {
#pragma unroll
                for (int e = 0; e < 4; ++e) { const f32x4 w0 = slab[((i * 4 + e) * 2) * 64 + lane], w1 = slab[((i * 4 + e) * 2 + 1) * 64 + lane];
                    a[0] += y[e] * w0.x; a[1] += y[e] * w0.y; a[2] += y[e] * w0.z; a[3] += y[e] * w0.w;
                    a[4] += y[e] * w1.x; a[5] += y[e] * w1.y; a[6] += y[e] * w1.z; a[7] += y[e] * w1.w; }
            }
        }
        if constexpr (EXTRA) {
#pragma unroll
            for (int j = 0; j < 8; ++j) a[j] = wave_sum(a[j]);
            if (lane == 0) { *(float4*)(ba + (size_t)row * 8) = make_float4(a[0], a[1], a[2], a[3]); *(float4*)(ba + (size_t)row * 8 + 4) = make_float4(a[4], a[5], a[6], a[7]); }
        }
    }
}

__device__ __forceinline__ void phase_prep(const Params& p, LAS unsigned char* lds) {
    LAS float* tile = (LAS float*)lds;
    unsigned char* ws = p.ws;
    for (int t = blockIdx.x; t < 1920; t += gridDim.x) {
        const float* src; int ld, K, kt, nt_; bf16_t* dst; const float* ksc = nullptr;
        if (t < 832) { src = p.in[8]; ld = LDWIN; K = 1024; dst = (bf16_t*)(ws + WS_WT_IN); kt = t / 52; nt_ = t % 52; }
        else if (t < 1088) { const int t2 = t - 832; src = p.in[16]; ld = 1024; K = 1024; dst = (bf16_t*)(ws + WS_WT_OUT); kt = t2 >> 4; nt_ = t2 & 15; }
        else if (t < 1600) { const int t2 = t - 1088; src = p.in[18]; ld = 2048; K = 1024; dst = (bf16_t*)(ws + WS_WT_INC); ksc = p.in[17]; kt = t2 >> 5; nt_ = t2 & 31; }
        else if (t < 1664) { const int t2 = t - 1600, gq = t2 >> 4; src = p.in[19] + gq * 65536; ld = 256; K = 256; dst = (bf16_t*)(ws + WS_WT_GRP) + gq * 65536; kt = (t2 & 15) >> 2; nt_ = t2 & 3; }
        else { const int t2 = t - 1664; src = p.in[21]; ld = 1024; K = 1024; dst = (bf16_t*)(ws + WS_WT_OUTC); kt = t2 >> 4; nt_ = t2 & 15; }
        transpose_tile(src, ld, dst, K, kt * 64, nt_ * 64, tile, ksc);
    }
    { float* rs = (float*)(ws + WS_ROWSS); for (int i = blockIdx.x * 512 + threadIdx.x; i < MTOK; i += gridDim.x * 512) rs[i] = 0.f; }
    rmsnorm_rows<true>(p.in[0], p.in[1], p.in[7], p.in[8] + NZ, (bf16_t*)(ws + WS_XN), (float*)(ws + WS_BA), (LAS f32x4*)(lds + 32768));
}

constexpr int L_QS = 0, L_KS = 17408, L_KT = 34816, L_VT = 53248, L_AS = 71680, L_TU = 89088, L_TW = 98304, L_BG = 107520;

__device__ __forceinline__ void dn_prep(const Params& p, LAS unsigned char* lds) {
    const int tid = threadIdx.x, lane = tid & 63, wid = tid >> 6, fr = lane & 15, fq = lane >> 4;
    LAS bf16_t* Qs = (LAS bf16_t*)(lds + L_QS); LAS bf16_t* Ks = (LAS bf16_t*)(lds + L_KS); LAS bf16_t* Kts = (LAS bf16_t*)(lds + L_KT); LAS bf16_t* Vts = (LAS bf16_t*)(lds + L_VT);
    LAS float* As = (LAS float*)(lds + L_AS); LAS bf16_t* Tu = (LAS bf16_t*)(lds + L_TU); LAS bf16_t* Tw = (LAS bf16_t*)(lds + L_TW);
    LAS float* beta_s = (LAS float*)(lds + L_BG); LAS float* G_s = beta_s + 64;
    const bf16_t* Z = (const bf16_t*)(p.ws + WS_Z);
    const float* BA = (const float*)(p.ws + WS_BA);
    unsigned char* dn = (unsigned char*)p.out;
    LAS float* cw_s = (LAS float*)(lds + 108032);
    int hb = -1;
    for (int ci = blockIdx.x; ci < NCH; ci += gridDim.x) {
        const bool samp = ci >= 1024;
        if ((ci & 3) != hb) { hb = ci & 3;
            lds_barrier();
            for (int idx = tid; idx < 1536; idx += 512) { const int j = idx / 384, r = idx - j * 384; cw_s[idx] = p.in[12][j * 1536 + (r >> 7) * 512 + hb * 128 + (r & 127)]; }
            lds_barrier(); }
        int b, n, h, chs, row0, ntok;
        if (!samp) { h = ci & 3; n = (ci >> 2) & 31; b = ci >> 7; chs = ((b * 4 + h) << 5) + n; row0 = b * 2048 + n * 64; ntok = 64; }
        else { const int s = ci - 1024; h = s & 3; b = s >> 2; n = 0; chs = 1024 + s; row0 = MP + b * 16; ntok = 16; }
        bf16_t* gW = (bf16_t*)(dn + DN_W) + (size_t)chs * 8192; bf16_t* gQS = (bf16_t*)(dn + DN_QS) + (size_t)chs * 8192;
        bf16_t* gKT = (bf16_t*)(dn + DN_KT) + (size_t)chs * 8192; bf16_t* gQK = (bf16_t*)(dn + DN_QK) + (size_t)chs * 4096;
        bf16_t* gUT = (bf16_t*)(p.ws + WS_UT) + (size_t)chs * 8192; float* gG = (float*)(p.ws + WS_GB) + (size_t)chs * 64;
        if (wid == 0) {
            const bool valid = lane < ntok;
            float be = 0.f, gl = 0.f;
            if (valid) {
                const float bl = BA[(size_t)(row0 + lane) * 8 + h], al = BA[(size_t)(row0 + lane) * 8 + 4 + h] + p.in[14][h];
                be = __builtin_amdgcn_rcpf(1.0f + __expf(-bl));
                const float sp = al > 20.f ? al : log1pf(__expf(al));
                gl = -__expf(p.in[13][h]) * sp;
            }
#pragma unroll
            for (int o = 1; o < 64; o <<= 1) { const float t = __shfl_up(gl, o); if (lane >= o) gl += t; }
            beta_s[lane] = be; G_s[lane] = gl; gG[lane] = gl;
        }
        {
            int z2; asm volatile("v_mov_b32 %0, 0" : "=v"(z2));
            const int tid2 = tid + z2;
            const int t = tid2 >> 3, sub = tid2 & 7, d0 = sub * 16;
            const bool valid = t < ntok;
            const bool whist = valid && (samp || n == 31) && (t >= ntok - 3);
            float* hist_out = p.out + (samp ? O_SBC : O_PBC) + (size_t)(b * 3 + (t - (ntok - 3))) * 1536;
#pragma unroll
            for (int part = 0; part < 3; ++part) {
                bf16x8 raw[4][2];
#pragma unroll
                for (int j = 0; j < 4; ++j) { const int tt = t - 3 + j; int te = (tt >= 0 || (!samp && n > 0)) ? tt : 0; te = te < ntok ? te : ntok - 1;
                    const bf16_t* zp = Z + (size_t)(row0 + te) * NZ + ZC_BQKV + part * 512 + h * 128 + d0;
                    raw[j][0] = *(const bf16x8*)zp; raw[j][1] = *(const bf16x8*)(zp + 8); }
                const int c0 = part * 512 + h * 128 + d0;
                float y[16];
#pragma unroll
                for (int e = 0; e < 16; ++e) y[e] = 0.f;
#pragma unroll
                for (int j = 0; j < 4; ++j) {
                    const int tt = t - 3 + j;
                    float xv[16];
                    if (valid && (tt >= 0 || (!samp && n > 0))) {
#pragma unroll
                        for (int e = 0; e < 8; ++e) { xv[e] = bf2f(raw[j][0][e]); xv[8 + e] = bf2f(raw[j][1][e]); }
                    } else if (valid && samp) {
                        const float* hp = p.in[5] + (size_t)(b * 3 + (3 + tt)) * 1536 + c0;
#pragma unroll
                        for (int e4 = 0; e4 < 4; ++e4) { const float4 q4 = *(const float4*)(hp + e4 * 4); xv[e4 * 4] = q4.x; xv[e4 * 4 + 1] = q4.y; xv[e4 * 4 + 2] = q4.z; xv[e4 * 4 + 3] = q4.w; }
                    } else {
#pragma unroll
                        for (int e = 0; e < 16; ++e) xv[e] = 0.f;
                    }
                    const LAS float* cw = cw_s + j * 384 + part * 128 + d0;
#pragma unroll
                    for (int e4 = 0; e4 < 4; ++e4) { const f32x4 c4 = *(const LAS f32x4*)(cw + e4 * 4);
                        y[e4 * 4] += xv[e4 * 4] * c4[0]; y[e4 * 4 + 1] += xv[e4 * 4 + 1] * c4[1]; y[e4 * 4 + 2] += xv[e4 * 4 + 2] * c4[2]; y[e4 * 4 + 3] += xv[e4 * 4 + 3] * c4[3]; }
                    if (j == 3 && whist) {
#pragma unroll
                        for (int e4 = 0; e4 < 4; ++e4) *(float4*)(hist_out + c0 + e4 * 4) = make_float4(xv[e4 * 4], xv[e4 * 4 + 1], xv[e4 * 4 + 2], xv[e4 * 4 + 3]);
                    }
                }
                float ss = 0.f;
#pragma unroll
                for (int e = 0; e < 16; ++e) { y[e] = valid ? silu_f(y[e]) : 0.f; ss += y[e] * y[e]; }
                ss = sum8(ss);
                if (part < 2) { const float r = rsqrtf(ss + 1e-6f) * (part == 0 ? 0.08838834764831845f : 1.0f);
#pragma unroll
                    for (int e = 0; e < 16; ++e) y[e] *= r; }
                u32x4 w0, w1;
                w0.x = cvt_pk_bf16(y[0], y[1]); w0.y = cvt_pk_bf16(y[2], y[3]); w0.z = cvt_pk_bf16(y[4], y[5]); w0.w = cvt_pk_bf16(y[6], y[7]);
                w1.x = cvt_pk_bf16(y[8], y[9]); w1.y = cvt_pk_bf16(y[10], y[11]); w1.z = cvt_pk_bf16(y[12], y[13]); w1.w = cvt_pk_bf16(y[14], y[15]);
                if (part == 0) {
                    *(LAS u32x4*)(Qs + t * 136 + d0) = w0; *(LAS u32x4*)(Qs + t * 136 + d0 + 8) = w1;
                    bf16_t* qp = gQS + t * 128 + 32 * (sub >> 1) + 4 * (sub & 1);
                    *(u32x2*)(qp) = (u32x2){w0.x, w0.y}; *(u32x2*)(qp + 8) = (u32x2){w0.z, w0.w}; *(u32x2*)(qp + 16) = (u32x2){w1.x, w1.y}; *(u32x2*)(qp + 24) = (u32x2){w1.z, w1.w};
                } else if (part == 1) {
                    *(LAS u32x4*)(Ks + t * 136 + d0) = w0; *(LAS u32x4*)(Ks + t * 136 + d0 + 8) = w1;
#pragma unroll
                    for (int e = 0; e < 16; ++e) Kts[(d0 + e) * 72 + (t ^ (8 * sub))] = f2bf(y[e]);
                } else {
#pragma unroll
                    for (int e = 0; e < 16; ++e) Vts[(d0 + e) * 72 + (t ^ (8 * sub))] = f2bf(y[e]);
                }
            }
        }
        lds_barrier();
        {
            const int sel = wid >> 2, ti = wid & 3;
            int z3; asm volatile("v_mov_b32 %0, 0" : "=v"(z3));
            const int fr = ((tid + z3) & 15), fq = ((tid + z3) & 63) >> 4;
#pragma unroll
            for (int tj = 0; tj < 4; ++tj) {
                if (sel == 0) {
                    if (tj <= ti) {
                        f32x4 acc = {0.f, 0.f, 0.f, 0.f};
#pragma unroll
                        for (int kk = 0; kk < 4; ++kk) { const bf16x8 a = *(const LAS bf16x8*)(Ks + (16 * ti + fr) * 136 + kk * 32 + 8 * fq), bb = *(const LAS bf16x8*)(Ks + (16 * tj + fr) * 136 + kk * 32 + 8 * fq); acc = mfma16(a, bb, acc); }
                        const int j = 16 * tj + fr; const float Gj = G_s[j];
#pragma unroll
                        for (int jj = 0; jj < 4; ++jj) { const int i = 16 * ti + 4 * fq + jj;
                            As[i * 68 + j] = (i > j) ? beta_s[i] * acc[jj] * __expf(G_s[i] - Gj) : 0.f; }
                    }
                } else {
                    f32x4 acc = {0.f, 0.f, 0.f, 0.f};
                    if (tj <= ti) {
#pragma unroll
                        for (int kk = 0; kk < 4; ++kk) { const bf16x8 a = *(const LAS bf16x8*)(Ks + (16 * tj + fr) * 136 + kk * 32 + 8 * fq), bb = *(const LAS bf16x8*)(Qs + (16 * ti + fr) * 136 + kk * 32 + 8 * fq); acc = mfma16(a, bb, acc); }
                    }
                    const int i = 16 * ti + fr; const float Gi = G_s[i];
                    float v[4];
#pragma unroll
                    for (int jj = 0; jj < 4; ++jj) { const int j = 16 * tj + 4 * fq + jj; v[jj] = (i >= j) ? acc[jj] * __expf(Gi - G_s[j]) : 0.f; }
                    u32x2 w; w.x = cvt_pk_bf16(v[0], v[1]); w.y = cvt_pk_bf16(v[2], v[3]);
                    *(u32x2*)(gQK + i * 64 + 32 * (tj >> 1) + 8 * fq + 4 * (tj & 1)) = w;
                }
            }
        }
        lds_barrier();
        if (wid == 0 && samp) {
            float T[16];
            int zoff; asm volatile("v_mov_b32 %0, 0" : "=v"(zoff));
            const LAS float* Asz = As + zoff;
            const float bc = beta_s[lane], wcf = bc * __expf(G_s[lane]);
            int lo2 = lane; asm volatile("" : "+v"(lo2));
            LAS bf16_t* tub = Tu + lo2; LAS bf16_t* twb = Tw + lo2;
#pragma unroll
            for (int i = 0; i < 16; ++i) {
                float a0 = (lane == i) ? 1.f : 0.f, a1 = 0.f;
#pragma unroll
                for (int j4 = 0; j4 < (i + 3) / 4; ++j4) {
                    const f32x4 av = *(const LAS f32x4*)(Asz + i * 68 + j4 * 4);
#pragma unroll
                    for (int e = 0; e < 4; ++e) { const int jx = j4 * 4 + e; if (jx < i) { if (jx & 1) a1 -= av[e] * T[jx]; else a0 -= av[e] * T[jx]; } }
                }
                T[i] = a0 + a1;
                tub[i * 72] = f2bf(T[i] * bc); twb[i * 72] = f2bf(T[i] * wcf);
            }
#pragma unroll
            for (int i = 16; i < 64; ++i) { tub[i * 72] = 0; twb[i * 72] = 0; }
        } else
        if (wid == 0) {
            float T[64];
            int zoff; asm volatile("v_mov_b32 %0, 0" : "=v"(zoff));
            const LAS float* Asz = As + zoff;
            const float bc = beta_s[lane], wcf = bc * __expf(G_s[lane]);
            int lo2 = lane; asm volatile("" : "+v"(lo2));
            LAS bf16_t* tub = Tu + lo2; LAS bf16_t* twb = Tw + lo2;
            f32x4 rlo[2][8], rhi[8];
            T[0] = (lane == 0) ? 1.f : 0.f;
            tub[0] = f2bf(T[0] * bc); twb[0] = f2bf(T[0] * wcf);
            rlo[1][0] = *(const LAS f32x4*)(Asz + 68);
#pragma unroll
            for (int i = 1; i < 64; ++i) {
#pragma unroll
                for (int j4 = 8; j4 < (i + 3) / 4; ++j4) rhi[j4 - 8] = *(const LAS f32x4*)(Asz + i * 68 + j4 * 4);
                if (i + 1 < 64) {
#pragma unroll
                    for (int j4 = 0; j4 < ((i + 4) / 4 < 8 ? (i + 4) / 4 : 8); ++j4) rlo[(i + 1) & 1][j4] = *(const LAS f32x4*)(Asz + (i + 1) * 68 + j4 * 4);
                }
                float a0 = (lane == i) ? 1.f : 0.f, a1 = 0.f, a2 = 0.f, a3 = 0.f;
#pragma unroll
                for (int j4 = 0; j4 < (i + 3) / 4; ++j4) {
                    const f32x4 av = (j4 < 8) ? rlo[i & 1][j4 & 7] : rhi[(j4 - 8) & 7];
                    if (j4 * 4 + 0 < i) a0 -= av[0] * T[j4 * 4 + 0];
                    if (j4 * 4 + 1 < i) a1 -= av[1] * T[j4 * 4 + 1];
                    if (j4 * 4 + 2 < i) a2 -= av[2] * T[j4 * 4 + 2];
                    if (j4 * 4 + 3 < i) a3 -= av[3] * T[j4 * 4 + 3];
                }
                T[i] = (a0 + a1) + (a2 + a3);
                tub[i * 72] = f2bf(T[i] * bc); twb[i * 72] = f2bf(T[i] * wcf);
                __builtin_amdgcn_sched_barrier(0);
            }
        }
        lds_barrier();
        {
            const int td = wid;
            int z5; asm volatile("v_mov_b32 %0, 0" : "=v"(z5));
            const int fr = ((tid + z5) & 15), fq = ((tid + z5) & 63) >> 4;
#pragma unroll
            for (int tt = 0; tt < 4; ++tt) {
                f32x4 au = {0.f, 0.f, 0.f, 0.f}, aw = {0.f, 0.f, 0.f, 0.f};
#pragma unroll
                for (int kk = 0; kk < 2; ++kk) {
                    const bf16x8 tu = *(const LAS bf16x8*)(Tu + (16 * tt + fr) * 72 + kk * 32 + 8 * fq), vt = *(const LAS bf16x8*)(Vts + (16 * td + fr) * 72 + ((kk * 32 + 8 * fq) ^ (8 * td)));
                    au = mfma16(tu, vt, au);
                    const bf16x8 kt = *(const LAS bf16x8*)(Kts + (16 * td + fr) * 72 + ((kk * 32 + 8 * fq) ^ (8 * td))), tw = *(const LAS bf16x8*)(Tw + (16 * tt + fr) * 72 + kk * 32 + 8 * fq);
                    aw = mfma16(kt, tw, aw);
                }
                u32x2 wu; wu.x = cvt_pk_bf16(au[0], au[1]); wu.y = cvt_pk_bf16(au[2], au[3]);
                *(u32x2*)(gUT + (16 * td + fr) * 64 + 16 * tt + 4 * fq) = wu;
                u32x2 ww; ww.x = cvt_pk_bf16(aw[0], aw[1]); ww.y = cvt_pk_bf16(aw[2], aw[3]);
                *(u32x2*)(gW + (16 * tt + fr) * 128 + 32 * (td >> 1) + 8 * fq + 4 * (td & 1)) = ww;
            }
#pragma unroll
            for (int q = tid + z5; q < 1024; q += 512) { const int dk = q >> 3, c8 = q & 7, u = c8 >> 2, f = c8 & 3;
                const int sw = 8 * ((dk >> 4) & 7);
                const u32x2 lo = *(const LAS u32x2*)(Kts + dk * 72 + ((32 * u + 4 * f) ^ sw)), hi = *(const LAS u32x2*)(Kts + dk * 72 + ((32 * u + 16 + 4 * f) ^ sw));
                *(u32x4*)(gKT + dk * 64 + 8 * c8) = (u32x4){lo.x, lo.y, hi.x, hi.y}; }
        }
        lds_barrier();
    }
}

__device__ __forceinline__ void attn_items(const Params& p, LAS unsigned char* lds, int ai0, int aistride) {
    const int tid = threadIdx.x, lane = tid & 63, wid = tid >> 6, fr = lane & 15, fq = lane >> 4;
    LAS bf16_t* K_s = (LAS bf16_t*)lds;
    LAS bf16_t* Vt_s = (LAS bf16_t*)(lds + 27648);
    const bf16_t* Z = (const bf16_t*)(p.ws + WS_Z);
    bf16_t* CAT = (bf16_t*)(p.ws + WS_CAT);
    for (int ai = ai0; ai < 576; ai += aistride) {
        const bool samp = ai >= 512;
        int b, c, g, nkeys, ntt, row0, krow0, nkc;
        if (!samp) { g = ai & 1; c = (ai >> 1) & 31; b = ai >> 6; nkc = (c < 2 ? c : 2) + 1; nkeys = 64 * nkc; ntt = 4; row0 = b * 2048 + c * 64; krow0 = row0 - (nkc - 1) * 64; }
        else { const int s = ai - 512; g = s & 1; b = s >> 1; c = 0; nkc = 0; nkeys = 160; ntt = 1; row0 = MP + b * 16; krow0 = 0; }
        for (int q = tid; q < nkeys * 8; q += 512) {
            const int key = q >> 3, d0 = (q & 7) * 8;
            float kf[8], vf[8]; bool donorm = false;
            if (!samp || (key >= 128 && key < 144)) {
                const int row = samp ? row0 + key - 128 : krow0 + key;
                const bf16x8 kr = *(const bf16x8*)(Z + (size_t)row * NZ + ZC_AK + g * 64 + d0), vr = *(const bf16x8*)(Z + (size_t)row * NZ + ZC_AV + g * 64 + d0);
#pragma unroll
                for (int e = 0; e < 8; ++e) { kf[e] = bf2f(kr[e]); vf[e] = bf2f(vr[e]); }
                donorm = true;
            } else if (key < 128) {
                const size_t o = ((size_t)(b * 128 + key) * 2 + g) * 64 + d0;
                const float4 k0 = *(const float4*)(p.in[2] + o), k1 = *(const float4*)(p.in[2] + o + 4), v0 = *(const float4*)(p.in[3] + o), v1 = *(const float4*)(p.in[3] + o + 4);
                kf[0] = k0.x; kf[1] = k0.y; kf[2] = k0.z; kf[3] = k0.w; kf[4] = k1.x; kf[5] = k1.y; kf[6] = k1.z; kf[7] = k1.w;
                vf[0] = v0.x; vf[1] = v0.y; vf[2] = v0.z; vf[3] = v0.w; vf[4] = v1.x; vf[5] = v1.y; vf[6] = v1.z; vf[7] = v1.w;
            } else {
#pragma unroll
                for (int e = 0; e < 8; ++e) { kf[e] = 0.f; vf[e] = 0.f; }
            }
            float ss = 0.f;
#pragma unroll
            for (int e = 0; e < 8; ++e) ss += kf[e] * kf[e];
            ss = sum8(ss);
            if (donorm) { const float r = rsqrtf(ss * (1.0f / 64.0f) + 1e-6f);
                const float4 n0 = *(const float4*)(p.in[10] + d0), n1 = *(const float4*)(p.in[10] + d0 + 4);
                kf[0] *= r * n0.x; kf[1] *= r * n0.y; kf[2] *= r * n0.z; kf[3] *= r * n0.w; kf[4] *= r * n1.x; kf[5] *= r * n1.y; kf[6] *= r * n1.z; kf[7] *= r * n1.w; }
            u32x4 w; w.x = cvt_pk_bf16(kf[0], kf[1]); w.y = cvt_pk_bf16(kf[2], kf[3]); w.z = cvt_pk_bf16(kf[4], kf[5]); w.w = cvt_pk_bf16(kf[6], kf[7]);
            *(LAS u32x4*)(K_s + key * 72 + d0) = w;
#pragma unroll
            for (int e = 0; e < 8; ++e) Vt_s[(d0 + e) * 200 + key] = f2bf(vf[e]);
            float* ok = nullptr; float* ov = nullptr;
            if (!samp) { if (c >= 30 && key >= nkeys - 64) { const int t = c * 64 + (key - (nkeys - 64)) - 1920; const size_t o = ((size_t)(b * 128 + t) * 2 + g) * 64 + d0; ok = p.out + O_PAK + o; ov = p.out + O_PAV + o; } }
            else if (key >= 128 && key < 144) { const size_t o = ((size_t)(b * 16 + key - 128) * 2 + g) * 64 + d0; ok = p.out + O_SAK + o; ov = p.out + O_SAV + o; }
            if (ok) { *(float4*)ok = make_float4(kf[0], kf[1], kf[2], kf[3]); *(float4*)(ok + 4) = make_float4(kf[4], kf[5], kf[6], kf[7]);
                      *(float4*)ov = make_float4(vf[0], vf[1], vf[2], vf[3]); *(float4*)(ov + 4) = make_float4(vf[4], vf[5], vf[6], vf[7]); }
        }
        lds_barrier();
        const int nqt = 4 * ntt, nkt = nkeys >> 4;
        for (int qq = 0; qq < 2; ++qq) {
            const int qt = wid * 2 + qq;
            if (qt < nqt) {
                const int r = qt / ntt, tok0 = 16 * (qt % ntt), hh = g * 4 + r;
                const size_t qrow = (size_t)(row0 + tok0 + fr);
                bf16x8 Qf[2];
                {
                    const bf16x8 r0 = *(const bf16x8*)(Z + qrow * NZ + ZC_AQ + hh * 64 + 8 * fq), r1 = *(const bf16x8*)(Z + qrow * NZ + ZC_AQ + hh * 64 + 32 + 8 * fq);
                    float q0[8], q1[8]; float ss = 0.f;
#pragma unroll
                    for (int e = 0; e < 8; ++e) { q0[e] = bf2f(r0[e]); q1[e] = bf2f(r1[e]); ss += q0[e] * q0[e] + q1[e] * q1[e]; }
                    ss += __shfl_xor(ss, 16); ss += __shfl_xor(ss, 32);
                    const float rq = rsqrtf(ss * (1.0f / 64.0f) + 1e-6f) * 0.125f;
                    const float4 na = *(const float4*)(p.in[9] + 8 * fq), nb = *(const float4*)(p.in[9] + 8 * fq + 4), nc = *(const float4*)(p.in[9] + 32 + 8 * fq), nd = *(const float4*)(p.in[9] + 32 + 8 * fq + 4);
                    u32x4 w0, w1;
                    w0.x = cvt_pk_bf16(q0[0] * rq * na.x, q0[1] * rq * na.y); w0.y = cvt_pk_bf16(q0[2] * rq * na.z, q0[3] * rq * na.w);
                    w0.z = cvt_pk_bf16(q0[4] * rq * nb.x, q0[5] * rq * nb.y); w0.w = cvt_pk_bf16(q0[6] * rq * nb.z, q0[7] * rq * nb.w);
                    w1.x = cvt_pk_bf16(q1[0] * rq * nc.x, q1[1] * rq * nc.y); w1.y = cvt_pk_bf16(q1[2] * rq * nc.z, q1[3] * rq * nc.w);
                    w1.z = cvt_pk_bf16(q1[4] * rq * nd.x, q1[5] * rq * nd.y); w1.w = cvt_pk_bf16(q1[6] * rq * nd.z, q1[7] * rq * nd.w);
                    Qf[0] = __builtin_bit_cast(bf16x8, w0); Qf[1] = __builtin_bit_cast(bf16x8, w1);
                }
                const float slope = exp2f(-(float)(hh + 1));
                const float sink = p.in[11][hh];
                const int qoff = samp ? (tok0 + fr + 128) : ((nkc - 1) * 64 + tok0 + fr);
                f32x4 s[12]; float mx = sink;
#pragma unroll
                for (int kt = 0; kt < 12; ++kt) {
                    if (kt < nkt) {
                        f32x4 acc = {0.f, 0.f, 0.f, 0.f};
#pragma unroll
                        for (int kk = 0; kk < 2; ++kk) { const bf16x8 a = *(const LAS bf16x8*)(K_s + (16 * kt + fr) * 72 + 32 * kk + 8 * fq); acc = mfma16(a, Qf[kk], acc); }
#pragma unroll
                        for (int jj = 0; jj < 4; ++jj) { const int key = 16 * kt + 4 * fq + jj; const bool valid = !samp || key < 144;
                            const float sv = valid ? acc[jj] - slope * fabsf((float)(qoff - key)) : -1e30f; s[kt][jj] = sv; mx = fmaxf(mx, sv); }
                    } else { s[kt] = (f32x4){-1e30f, -1e30f, -1e30f, -1e30f}; }
                }
                mx = fmaxf(mx, __shfl_xor(mx, 16)); mx = fmaxf(mx, __shfl_xor(mx, 32));
                float l = 0.f;
#pragma unroll
                for (int kt = 0; kt < 12; ++kt)
#pragma unroll
                    for (int jj = 0; jj < 4; ++jj) { const float pv = __expf(s[kt][jj] - mx); s[kt][jj] = pv; l += pv; }
                l += __shfl_xor(l, 16); l += __shfl_xor(l, 32);
                l += __expf(sink - mx);
                const float inv = __builtin_amdgcn_rcpf(l);
                f32x4 o[4];
#pragma unroll
                for (int dt = 0; dt < 4; ++dt) o[dt] = (f32x4){0.f, 0.f, 0.f, 0.f};
#pragma unroll
                for (int u = 0; u < 6; ++u) {
                    if (2 * u < nkt) {
                        const bf16x8 Pf = pack8(s[2 * u], s[2 * u + 1]);
#pragma unroll
                        for (int dt = 0; dt < 4; ++dt) {
                            const u32x2 lo = *(const LAS u32x2*)(Vt_s + (16 * dt + fr) * 200 + 32 * u + 4 * fq), hi = *(const LAS u32x2*)(Vt_s + (16 * dt + fr) * 200 + 32 * u + 16 + 4 * fq);
                            o[dt] = mfma16(cat8(lo, hi), Pf, o[dt]);
                        }
                    }
                }
#pragma unroll
                for (int dt = 0; dt < 4; ++dt) {
                    const int d = 16 * dt + 4 * fq;
                    const bf16x4 ag = *(const bf16x4*)(Z + qrow * NZ + ZC_AG + hh * 64 + d);
                    u32x2 w; w.x = cvt_pk_bf16(o[dt][0] * inv * silu_f(bf2f(ag[0])), o[dt][1] * inv * silu_f(bf2f(ag[1])));
                    w.y = cvt_pk_bf16(o[dt][2] * inv * silu_f(bf2f(ag[2])), o[dt][3] * inv * silu_f(bf2f(ag[3])));
                    *(u32x2*)(CAT + qrow * DM + hh * 64 + d) = w;
                }
            }
        }
        lds_barrier();
    }
}

constexpr int SC_W = 0, SC_QS = 17408, SC_KT = 34816, SC_QK = 53248, SC_BUF = 62464;
template <bool PROMPT>
__device__ __forceinline__ void scan_block(const Params& p, LAS unsigned char* lds, int chs0, int nsteps, const float* s0, float* sfin, int rowbase, int ntok, int h, int half) {
    const int tid = threadIdx.x, lane = tid & 63, wid = tid >> 6, fr = lane & 15, fq = lane >> 4, slice = half * 4 + (wid & 3), dv = slice * 16 + fr;
    const bool comp = wid < 4;
    const unsigned char* dn = (const unsigned char*)p.out;
#define SC_BAR() do { asm volatile("s_waitcnt lgkmcnt(0)" ::: "memory"); __builtin_amdgcn_s_barrier(); asm volatile("" ::: "memory"); } while (0)
    if (!comp) {
        const int t = tid - 256, wrow = t >> 4, wc = t & 15, krow = t >> 3, kc = t & 7;
        u32x4 A[14], Bq[14];
#define SC_LOAD(R, chs) do { \
            const bf16_t* W_ = (const bf16_t*)(dn + DN_W) + (size_t)(chs) * 8192; const bf16_t* Q_ = (const bf16_t*)(dn + DN_QS) + (size_t)(chs) * 8192; \
            const bf16_t* K_ = (const bf16_t*)(dn + DN_KT) + (size_t)(chs) * 8192; const bf16_t* X_ = (const bf16_t*)(dn + DN_QK) + (size_t)(chs) * 4096; \
            _Pragma("unroll") for (int i_ = 0; i_ < 4; ++i_) { R[i_] = *(const u32x4*)(W_ + (wrow + 16 * i_) * 128 + wc * 8); R[4 + i_] = *(const u32x4*)(Q_ + (wrow + 16 * i_) * 128 + wc * 8); \
                R[8 + i_] = *(const u32x4*)(K_ + (krow + 32 * i_) * 64 + kc * 8); } \
            _Pragma("unroll") for (int i_ = 0; i_ < 2; ++i_) R[12 + i_] = *(const u32x4*)(X_ + (krow + 32 * i_) * 64 + kc * 8); } while (0)
#define SC_STORE(R, buf) do { LAS unsigned char* B_ = lds + (buf) * SC_BUF; \
            _Pragma("unroll") for (int i_ = 0; i_ < 4; ++i_) { *(LAS u32x4*)(B_ + SC_W + (wrow + 16 * i_) * 272 + wc * 16) = R[i_]; *(LAS u32x4*)(B_ + SC_QS + (wrow + 16 * i_) * 272 + wc * 16) = R[4 + i_]; \
                *(LAS u32x4*)(B_ + SC_KT + (krow + 32 * i_) * 144 + kc * 16) = R[8 + i_]; } \
            _Pragma("unroll") for (int i_ = 0; i_ < 2; ++i_) *(LAS u32x4*)(B_ + SC_QK + (krow + 32 * i_) * 144 + kc * 16) = R[12 + i_]; } while (0)
        SC_LOAD(A, chs0);
        SC_STORE(A, 0);
        SC_BAR();
        if constexpr (PROMPT) {
            SC_LOAD(A, chs0 + 1); SC_LOAD(Bq, chs0 + 2);
            for (int n = 0; n < nsteps; n += 2) {
                SC_STORE(A, 1);  { const int c = (n + 3 < nsteps) ? n + 3 : nsteps - 1; SC_LOAD(A, chs0 + c); }  SC_BAR();
                SC_STORE(Bq, 0); { const int c = (n + 4 < nsteps) ? n + 4 : nsteps - 1; SC_LOAD(Bq, chs0 + c); } SC_BAR();
            }
        } else {
            SC_BAR();
        }
#undef SC_LOAD
#undef SC_STORE
        return;
    }
    bf16_t* CAT = (bf16_t*)(p.ws + WS_CAT);
    f32x4 ST[8];
#pragma unroll
    for (int T = 0; T < 8; ++T)
#pragma unroll
        for (int jj = 0; jj < 4; ++jj) ST[T][jj] = s0 ? s0[(size_t)(16 * T + 4 * fq + jj) * 128 + dv] : 0.f;
    bf16x4 u4n[4]; f32x4 g4n[4]; float Gln;
#define SC_UG(chs) do { const bf16_t* U_ = (const bf16_t*)(p.ws + WS_UT) + (size_t)(chs) * 8192; const float* G_ = (const float*)(p.ws + WS_GB) + (size_t)(chs) * 64; \
        _Pragma("unroll") for (int tt = 0; tt < 4; ++tt) { u4n[tt] = *(const bf16x4*)(U_ + dv * 64 + 16 * tt + 4 * fq); g4n[tt] = *(const f32x4*)(G_ + 16 * tt + 4 * fq); } \
        Gln = G_[63]; } while (0)
    SC_UG(chs0);
    SC_BAR();
    for (int n = 0; n < nsteps; ++n) {
        bf16x4 u4[4]; f32x4 g4[4]; const float Glc = Gln;
#pragma unroll
        for (int tt = 0; tt < 4; ++tt) { u4[tt] = u4n[tt]; g4[tt] = g4n[tt]; }
        if constexpr (PROMPT) { const int c = (n + 1 < nsteps) ? n + 1 : nsteps - 1; SC_UG(chs0 + c); }
        __builtin_amdgcn_sched_barrier(0);
        const LAS unsigned char* B = lds + (n & 1) * SC_BUF;
        bf16x8 Sb[4];
#pragma unroll
        for (int P = 0; P < 4; ++P) Sb[P] = pack8(ST[2 * P], ST[2 * P + 1]);
        f32x4 ws[4], qs[4];
        bf16x8 fa[8];
#pragma unroll
        for (int tt = 0; tt < 4; ++tt) {
#pragma unroll
            for (int P = 0; P < 4; ++P) { fa[P] = *(const LAS bf16x8*)(B + SC_W + (16 * tt + fr) * 272 + (32 * P + 8 * fq) * 2);
                                          fa[4 + P] = *(const LAS bf16x8*)(B + SC_QS + (16 * tt + fr) * 272 + (32 * P + 8 * fq) * 2); }
            __builtin_amdgcn_sched_barrier(0);
            ws[tt] = (f32x4){0.f, 0.f, 0.f, 0.f}; qs[tt] = (f32x4){0.f, 0.f, 0.f, 0.f};
#pragma unroll
            for (int P = 0; P < 4; ++P) { ws[tt] = mfma16(fa[P], Sb[P], ws[tt]); qs[tt] = mfma16(fa[4 + P], Sb[P], qs[tt]); }
            __builtin_amdgcn_sched_barrier(0);
        }
        bf16x8 fq_[8], fk[8];
#pragma unroll
        for (int tt = 0; tt < 4; ++tt)
#pragma unroll
            for (int u = 0; u < 2; ++u) fq_[tt * 2 + u] = *(const LAS bf16x8*)(B + SC_QK + (16 * tt + fr) * 144 + (32 * u + 8 * fq) * 2);
        __builtin_amdgcn_sched_barrier(0);
        f32x4 vn[4], vd[4];
#pragma unroll
        for (int tt = 0; tt < 4; ++tt)
#pragma unroll
            for (int jj = 0; jj < 4; ++jj) { vn[tt][jj] = bf2f(u4[tt][jj]) - ws[tt][jj]; vd[tt][jj] = vn[tt][jj] * __expf(Glc - g4[tt][jj]); }
        bf16x8 Vb[2], Vd[2];
#pragma unroll
        for (int u = 0; u < 2; ++u) { Vb[u] = pack8(vn[2 * u], vn[2 * u + 1]); Vd[u] = pack8(vd[2 * u], vd[2 * u + 1]); }
        f32x4 o[4];
#pragma unroll
        for (int tt = 0; tt < 4; ++tt)
#pragma unroll
            for (int jj = 0; jj < 4; ++jj) o[tt][jj] = qs[tt][jj] * __expf(g4[tt][jj]);
        const float gt = __expf(Glc);
#pragma unroll
        for (int T = 0; T < 8; ++T) ST[T] = ST[T] * gt;
        __builtin_amdgcn_sched_barrier(0);
#pragma unroll
        for (int T = 0; T < 4; ++T)
#pragma unroll
            for (int u = 0; u < 2; ++u) fk[T * 2 + u] = *(const LAS bf16x8*)(B + SC_KT + (16 * T + fr) * 144 + (32 * u + 8 * fq) * 2);
        __builtin_amdgcn_sched_barrier(0);
#pragma unroll
        for (int tt = 0; tt < 4; ++tt)
#pragma unroll
            for (int u = 0; u < 2; ++u) o[tt] = mfma16(fq_[tt * 2 + u], Vb[u], o[tt]);
        __builtin_amdgcn_sched_barrier(0);
#pragma unroll
        for (int T = 0; T < 4; ++T)
#pragma unroll
            for (int u = 0; u < 2; ++u) fq_[T * 2 + u] = *(const LAS bf16x8*)(B + SC_KT + (16 * (4 + T) + fr) * 144 + (32 * u + 8 * fq) * 2);
        __builtin_amdgcn_sched_barrier(0);
#pragma unroll
        for (int T = 0; T < 4; ++T)
#pragma unroll
            for (int u = 0; u < 2; ++u) ST[T] = mfma16(fk[T * 2 + u], Vd[u], ST[T]);
        __builtin_amdgcn_sched_barrier(0);
#pragma unroll
        for (int T = 0; T < 4; ++T)
#pragma unroll
            for (int u = 0; u < 2; ++u) ST[4 + T] = mfma16(fq_[T * 2 + u], Vd[u], ST[4 + T]);
#pragma unroll
        for (int tt = 0; tt < 4; ++tt)
#pragma unroll
            for (int jj = 0; jj < 4; ++jj) {
                const int tok = 16 * tt + 4 * fq + jj;
                if constexpr (PROMPT) {
                    const unsigned row = (unsigned)(rowbase + n * 64 + tok);
                    CAT[row * (unsigned)DM + (unsigned)(512 + h * 128 + dv)] = f2bf(o[tt][jj]);
                } else {
                    const unsigned row = (unsigned)(rowbase + n * 64 + (tok < ntok ? tok : 0));
                    if (tok < ntok) CAT[row * (unsigned)DM + (unsigned)(512 + h * 128 + dv)] = f2bf(o[tt][jj]);
                }
            }
        SC_BAR();
    }
#undef SC_UG
#undef SC_BAR
#pragma unroll
    for (int T = 0; T < 8; ++T)
#pragma unroll
        for (int jj = 0; jj < 4; ++jj) sfin[(size_t)(16 * T + 4 * fq + jj) * 128 + dv] = ST[T][jj];
}

__device__ __forceinline__ void phase_scan(const Params& p, LAS unsigned char* lds) {
    if (blockIdx.x < 64) {
        const int pair = blockIdx.x >> 1, half = blockIdx.x & 1, b = pair >> 2, h = pair & 3;
        scan_block<true>(p, lds, pair * 32, 32, nullptr, p.out + O_PBS + (size_t)pair * 16384, b * 2048, 64, h, half);
    } else {
        const int bi = blockIdx.x - 64, nb = gridDim.x - 64;
        for (int s2 = bi; s2 < 256; s2 += nb) { const int s = s2 >> 1, half = s2 & 1, b = s >> 2, h = s & 3;
            scan_block<false>(p, lds, 1024 + s, 1, p.in[4] + (size_t)s * 16384, p.out + O_SBS + (size_t)s * 16384, MP + b * 16, 16, h, half); }
        attn_items(p, lds, bi, nb);
        { pg8::StaticOrder S; pg8::Gemm g{(const bf16_t*)(p.ws + WS_XN), (const bf16_t*)(p.ws + WS_WT_IN) + (size_t)ZC_BG * 1024, MTOK, 512, 1024, 1024, 0}; S.init(MTOK, 512, nb, bi);
          pg8::EpiZ E{(bf16_t*)(p.ws + WS_Z) + ZC_BG, NZ}; pg8::gemm_phase(lds, g, S, E); }
    }
}

__device__ __forceinline__ void phase_onorm(const Params& p) {
    const bf16_t* Z = (const bf16_t*)(p.ws + WS_Z);
    bf16_t* CAT = (bf16_t*)(p.ws + WS_CAT);
    const int nthr = gridDim.x * 512, total = MTOK * 64;
    const int c8 = (threadIdx.x & 63) * 8, d = c8 & 127;
    const float4 n0 = *(const float4*)(p.in[15] + d), n1 = *(const float4*)(p.in[15] + d + 4);
    const float nn[8] = {n0.x, n0.y, n0.z, n0.w, n1.x, n1.y, n1.z, n1.w};
    for (int idx = blockIdx.x * 512 + threadIdx.x; idx < total; idx += 4 * nthr) {
        bf16x8 ov[4], gv[4];
#pragma unroll
        for (int q = 0; q < 4; ++q) { const int id = idx + q * nthr; const int row = (id < total ? id : idx) >> 6;
            ov[q] = *(const bf16x8*)(CAT + (size_t)row * DM + 512 + c8); gv[q] = *(const bf16x8*)(Z + (size_t)row * NZ + ZC_BG + c8); }
#pragma unroll
        for (int q = 0; q < 4; ++q) {
            const int id = idx + q * nthr;
            float y[8]; float ss = 0.f;
#pragma unroll
            for (int e = 0; e < 8; ++e) { y[e] = bf2f(ov[q][e]); ss += y[e] * y[e]; }
            ss = sum16(ss);
            const float r = rsqrtf(ss * (1.0f / 128.0f) + 1e-6f);
#pragma unroll
            for (int e = 0; e < 8; ++e) y[e] = y[e] * r * nn[e] * silu_f(bf2f(gv[q][e]));
            u32x4 w; w.x = cvt_pk_bf16(y[0], y[1]); w.y = cvt_pk_bf16(y[2], y[3]); w.z = cvt_pk_bf16(y[4], y[5]); w.w = cvt_pk_bf16(y[6], y[7]);
            if (id < total) *(u32x4*)(CAT + (size_t)(id >> 6) * DM + 512 + c8) = w;
        }
    }
}

template <int W>
__device__ __forceinline__ void pool_item(const Params& p, const bf16_t* __restrict__ U, bf16_t* __restrict__ PO, bool samp, int b, int rowb, int t0, int c4) {
    constexpr int NR = 8;
    const float* hist = p.in[6] + (size_t)b * 15 * 1024;
    f32x4 r[W + NR - 1];
#pragma unroll
    for (int j = 0; j < W + NR - 1; ++j) {
        const int tp = t0 - W + 1 + j;
        if (tp >= 0) { const bf16x4 v = *(const bf16x4*)(U + (size_t)(rowb + tp) * DM + c4); r[j] = (f32x4){bf2f(v[0]), bf2f(v[1]), bf2f(v[2]), bf2f(v[3])}; }
        else if (samp) r[j] = *(const f32x4*)(hist + (size_t)(15 + tp) * 1024 + c4);
        else r[j] = (f32x4){0.f, 0.f, 0.f, 0.f};
    }
    f32x4 s = r[0];
#pragma unroll
    for (int j = 1; j < W; ++j) s += r[j];
#pragma unroll
    for (int k = 0; k < NR; ++k) {
        const int t = t0 + k;
        if (k > 0) s += r[k + W - 1] - r[k - 1];
        const f32x4 v = r[k + W - 1];
        const int cnt = samp ? W : ((t + 1) < W ? (t + 1) : W);
        const float ic = 1.0f / (float)cnt;
        u32x2 o; o.x = cvt_pk_bf16(s[0] * ic - v[0], s[1] * ic - v[1]); o.y = cvt_pk_bf16(s[2] * ic - v[2], s[3] * ic - v[3]);
        *(u32x2*)(PO + (size_t)(rowb + t) * DM + c4) = o;
        if (!samp) { if (t >= 2033) *(f32x4*)(p.out + O_PCP + ((size_t)b * 15 + (t - 2033)) * 1024 + c4) = v; }
        else if (t >= 1) *(f32x4*)(p.out + O_SCP + ((size_t)b * 15 + (t - 1)) * 1024 + c4) = v;
    }
}
__device__ __forceinline__ void phase_pool(const Params& p) {
    const bf16_t* U = (const bf16_t*)(p.ws + WS_U);
    bf16_t* PO = (bf16_t*)(p.ws + WS_POOL);
    const int nthr = gridDim.x * 512;
    for (int idx = blockIdx.x * 512 + threadIdx.x; idx < 2112 * 256; idx += nthr) {
        const int c4 = (idx & 255) * 4, rg = idx >> 8;
        const bool samp = rg >= 2048;
        int b, rowb, t0;
        if (!samp) { b = rg >> 8; rowb = b * 2048; t0 = (rg & 255) * 8; } else { const int s = rg - 2048; b = s >> 1; rowb = MP + b * 16; t0 = (s & 1) * 8; }
        const int g = c4 >> 8;
        if (g == 0) pool_item<2>(p, U, PO, samp, b, rowb, t0, c4);
        else if (g == 1) pool_item<4>(p, U, PO, samp, b, rowb, t0, c4);
        else if (g == 2) pool_item<8>(p, U, PO, samp, b, rowb, t0, c4);
        else pool_item<16>(p, U, PO, samp, b, rowb, t0, c4);
    }
}

template <bool NORM> struct SEpiRes {
    const float* base; float* out; bf16_t* a3; const float* gvec; float* rowss;
    __device__ __forceinline__ void operator()(int row, int col, const f32x4& acc) const {
        if constexpr (NORM) { const f32x4 bv = *(const f32x4*)(base + (size_t)row * DM + col); const f32x4 v = acc + bv;
            float ss = (v[0] * v[0] + v[1] * v[1]) + (v[2] * v[2] + v[3] * v[3]);
            u32x2 w; w.x = cvt_pk_bf16(v[0], v[1]); w.y = cvt_pk_bf16(v[2], v[3]); *(u32x2*)(a3 + (size_t)row * DM + col) = w;
            ss += __shfl_xor(ss, 16); ss += __shfl_xor(ss, 32); if ((threadIdx.x & 48) == 0) atomicAdd(rowss + row, ss);
        } else { const bf16x4 hb = *(const bf16x4*)(a3 + (size_t)row * DM + col);
            *(f32x4*)(out + (size_t)row * DM + col) = acc + (f32x4){bf2f(hb[0]), bf2f(hb[1]), bf2f(hb[2]), bf2f(hb[3])}; } }
};
struct SEpiUG {
    bf16_t* U; bf16_t* SG; const float* rowss;
    __device__ __forceinline__ void operator()(int row, int col, const f32x4& acc) const {
        const f32x4 v = acc * rsqrtf(rowss[row] * (1.0f / 1024.0f) + 1e-6f);
        if (col < 1024) { u32x2 w; w.x = cvt_pk_bf16(v[0], v[1]); w.y = cvt_pk_bf16(v[2], v[3]); *(u32x2*)(U + (size_t)row * DM + col) = w; }
        else { u32x2 w; w.x = cvt_pk_bf16(silu_f(v[0]), silu_f(v[1])); w.y = cvt_pk_bf16(silu_f(v[2]), silu_f(v[3])); *(u32x2*)(SG + (size_t)row * DM + col - 1024) = w; } }
};
struct SEpiM {
    const float* scale; const bf16_t* SG; bf16_t* O;
    __device__ __forceinline__ void operator()(int row, int col, const f32x4& v) const {
        const f32x4 sc = *(const f32x4*)(scale + col); const bf16x4 gv = *(const bf16x4*)(SG + (size_t)row * DM + col);
        u32x2 w; w.x = cvt_pk_bf16(v[0] * sc[0] * bf2f(gv[0]), v[1] * sc[1] * bf2f(gv[1])); w.y = cvt_pk_bf16(v[2] * sc[2] * bf2f(gv[2]), v[3] * sc[3] * bf2f(gv[3]));
        *(u32x2*)(O + (size_t)row * DM + col) = w; }
};
template <int KS, class Epi>
__device__ __forceinline__ void small_gemm(const bf16_t* __restrict__ A, int lda, int a_grp_step, const bf16_t* __restrict__ Bt, int N, const Epi& E, LAS unsigned char* lds) {
    constexpr int K = KS * 128;
    const int lane = threadIdx.x & 63, wid = threadIdx.x >> 6, fr = lane & 15, fq = lane >> 4, th = wid >> 2, kq = wid & 3;
    LAS f32x4* red = (LAS f32x4*)lds;
    const int ntile = 16 * (N >> 5);
    for (int pair = blockIdx.x; pair * 2 < ntile; pair += gridDim.x) {
        const int tile = pair * 2 + th, tr = tile & 15, tc = tile >> 4, row0 = MP + tr * 32, col0 = tc * 32;
        const bf16_t* ap = A + (size_t)(row0 + fr) * lda + (col0 >> 8) * a_grp_step + kq * (KS * 32) + 8 * fq;
        const bf16_t* bp = Bt + (size_t)(col0 + fr) * K + kq * (KS * 32) + 8 * fq;
        bf16x8 a[KS][2], b[KS][2];
#pragma unroll
        for (int k = 0; k < KS; ++k)
#pragma unroll
            for (int m = 0; m < 2; ++m) { a[k][m] = *(const bf16x8*)(ap + (size_t)(16 * m) * lda + 32 * k); b[k][m] = *(const bf16x8*)(bp + (size_t)(16 * m) * K + 32 * k); }
        f32x4 acc[2][2];
#pragma unroll
        for (int mi = 0; mi < 2; ++mi)
#pragma unroll
            for (int ni = 0; ni < 2; ++ni) acc[mi][ni] = (f32x4){0.f, 0.f, 0.f, 0.f};
#pragma unroll
        for (int k = 0; k < KS; ++k)
#pragma unroll
            for (int mi = 0; mi < 2; ++mi)
#pragma unroll
                for (int ni = 0; ni < 2; ++ni) acc[mi][ni] = mfma16(b[k][ni], a[k][mi], acc[mi][ni]);
#pragma unroll
        for (int mi = 0; mi < 2; ++mi)
#pragma unroll
            for (int ni = 0; ni < 2; ++ni) red[(wid * 4 + mi * 2 + ni) * 64 + lane] = acc[mi][ni];
        lds_barrier();
        {
            const int sub = kq, mi = sub >> 1, ni = sub & 1;
            f32x4 s = red[((th * 4 + 0) * 4 + sub) * 64 + lane];
#pragma unroll
            for (int q = 1; q < 4; ++q) s += red[((th * 4 + q) * 4 + sub) * 64 + lane];
            E(row0 + 16 * mi + fr, col0 + 16 * ni + 4 * fq, s);
        }
        lds_barrier();
    }
}

#define XB_TMO      128
#define XB_XCNT(j)  (256  + 64 * (j))
#define XB_XSUB(j)  (1280 + 64 * (j))
#define XB_XGEN(j)  (2304 + 64 * (j))
#define XB_TOP      3328
#define XB_TOPGEN   3392
#define XCD_BAR_WORDS 3456
#define XB_SPIN_CAP (1u << 18)
__device__ __forceinline__ unsigned xb_ld(unsigned* p)              { return __hip_atomic_load(p, __ATOMIC_RELAXED, __HIP_MEMORY_SCOPE_AGENT); }
__device__ __forceinline__ unsigned xb_add(unsigned* p, unsigned v) { return __hip_atomic_fetch_add(p, v, __ATOMIC_RELAXED, __HIP_MEMORY_SCOPE_AGENT); }
__device__ __forceinline__ unsigned xb_xcc_id() { return (unsigned)__builtin_amdgcn_s_getreg((3 << 11) | 20) & 0xFu; }
#define XB_SPIN(cond, bar) do { unsigned _sp = 0; while (cond) { __builtin_amdgcn_s_sleep(1); \
    if ((++_sp & 255u) == 0u) { if (xb_ld(&(bar)[XB_TMO])) break; if (_sp > XB_SPIN_CAP) { atomicAdd(&(bar)[XB_TMO], 1u); break; } } } } while (0)
struct XcdBarrier { unsigned* bar; unsigned x; volatile LAS unsigned* st; };
__device__ __forceinline__ XcdBarrier xcd_barrier_post(unsigned* bar, volatile LAS unsigned* st) {
    XcdBarrier b; b.bar = bar; b.x = xb_xcc_id(); b.st = st;
    if (threadIdx.x == 0) (void)xb_add(&bar[XB_XCNT(b.x)], 1u);
    return b;
}
__device__ __forceinline__ void xcd_barrier_complete(unsigned* bar, unsigned x, unsigned& nloc, unsigned& nx) {
    const unsigned G = gridDim.x * gridDim.y * gridDim.z;
    unsigned sum, cnt, mine, sp = 0u;
    for (;;) {
        sum = 0u; cnt = 0u; mine = 0u;
#pragma unroll
        for (unsigned j = 0; j < 16; ++j) { const unsigned c = xb_ld(&bar[XB_XCNT(j)]); sum += c; cnt += (c > 0u) ? 1u : 0u; mine = (j == x) ? c : mine; }
        if (sum == G) break;
        __builtin_amdgcn_s_sleep(1);
        if ((++sp & 255u) == 0u) { if (xb_ld(&bar[XB_TMO])) break; if (sp > XB_SPIN_CAP) { atomicAdd(&bar[XB_TMO], 1u); break; } }
    }
    nloc = mine > 0u ? mine : 1u; nx = cnt > 0u ? cnt : 1u;
}
__device__ __forceinline__ void xcd_barrier(const XcdBarrier& b) {
    asm volatile("s_waitcnt vmcnt(0)" ::: "memory");
    __syncthreads();
    if (threadIdx.x == 0) {
        unsigned* bar = b.bar;
        __builtin_amdgcn_s_waitcnt(0);
        unsigned nloc = b.st[0], nx = b.st[1];
        if (nloc == 0u) { xcd_barrier_complete(bar, b.x, nloc, nx); b.st[0] = nloc; b.st[1] = nx; }
        const unsigned old = xb_add(&bar[XB_XSUB(b.x)], 1u);
        const unsigned gen = old / nloc;
        if (old + 1u == (gen + 1u) * nloc) {
            __builtin_amdgcn_fence(__ATOMIC_RELEASE, "agent");
            asm volatile("s_waitcnt vmcnt(0)" ::: "memory");
            const unsigned og = xb_add(&bar[XB_TOP], 1u);
            const unsigned tg = og / nx;
            if (og + 1u == (tg + 1u) * nx) xb_add(&bar[XB_TOPGEN], 1u);
            else XB_SPIN(xb_ld(&bar[XB_TOPGEN]) == tg, bar);
            __builtin_amdgcn_fence(__ATOMIC_ACQUIRE, "agent");
            xb_add(&bar[XB_XGEN(b.x)], 1u);
            asm volatile("s_waitcnt vmcnt(0)" ::: "memory");
        } else {
            XB_SPIN(xb_ld(&bar[XB_XGEN(b.x)]) == gen, bar);
            __builtin_amdgcn_fence(__ATOMIC_ACQUIRE, "agent");
            asm volatile("s_waitcnt vmcnt(0)" ::: "memory");
        }
    }
    __syncthreads();
}

constexpr int NPHASE = 11;
#ifndef PHMASK
#define PHMASK 0x7ff
#endif
#define PH_ON(k) (((PHMASK >> (k)) & 1) && p.ph_lo <= (k) && (k) < p.ph_hi)
#define PH_SYNC(k) do { if (p.ph_lo < (k) && (k) < p.ph_hi) xcd_barrier(xb); } while (0)
#ifndef MK_REP
#define MK_REP 0
#endif
#define PH_REP(k) (((MK_REP >> (k)) & 1) ? 2 : 1)
__global__ void __launch_bounds__(512, 2) mega(Params p) {
    extern __shared__ __attribute__((aligned(16))) unsigned char lds[];
    cg::grid_group grid = cg::this_grid();
    unsigned char* ws = p.ws;
    LAS unsigned char* L = (LAS unsigned char*)lds;
    if (p.ph_hi > NPHASE) grid.sync();
    volatile LAS unsigned* xst = (volatile LAS unsigned*)(L + pg8::STAGE_BYTES);
    if (threadIdx.x == 0) { xst[0] = 0u; xst[1] = 0u; xst[2] = 0u; xst[3] = 0u; }
    __syncthreads();
    const XcdBarrier xb = xcd_barrier_post((unsigned*)(ws + WS_BAR), xst);
    if (PH_ON(0)) for (int rep = 0; rep < PH_REP(0); ++rep) phase_prep(p, L);
    PH_SYNC(1);
    if (PH_ON(1)) { pg8::StaticOrder S; pg8::Gemm g{(const bf16_t*)(ws + WS_XN), (const bf16_t*)(ws + WS_WT_IN), MTOK, 2816, 1024, 1024, 0}; S.init(MTOK, 2816, gridDim.x, blockIdx.x);
        pg8::EpiZ E{(bf16_t*)(ws + WS_Z), NZ}; pg8::gemm_phase((LAS unsigned char*)lds, g, S, E); }
    PH_SYNC(2);
    if (PH_ON(2)) dn_prep(p, L);
    PH_SYNC(3);
    if (PH_ON(3)) phase_scan(p, L);
    PH_SYNC(4);
    if (PH_ON(4)) phase_onorm(p);
    PH_SYNC(5);
    if (PH_ON(5)) { pg8::StaticOrder S; const bool sfirst = (blockIdx.x & 1) != 0;
        if (sfirst) { SEpiRes<true> SE{p.in[1] - (size_t)MP * DM, p.out, (bf16_t*)(ws + WS_XN), p.in[17], (float*)(ws + WS_ROWSS)}; small_gemm<8>((const bf16_t*)(ws + WS_CAT), 1024, 0, (const bf16_t*)(ws + WS_WT_OUT), 1024, SE, L); }
        pg8::Gemm g{(const bf16_t*)(ws + WS_CAT), (const bf16_t*)(ws + WS_WT_OUT), MP, 1024, 1024, 1024, 0}; S.init(MP, 1024, gridDim.x, blockIdx.x);
        pg8::EpiRes<true> E{p.in[0], p.in[1], p.out, (bf16_t*)(ws + WS_XN), p.in[17], (float*)(ws + WS_ROWSS)}; pg8::gemm_phase((LAS unsigned char*)lds, g, S, E);
        if (!sfirst) { SEpiRes<true> SE{p.in[1] - (size_t)MP * DM, p.out, (bf16_t*)(ws + WS_XN), p.in[17], (float*)(ws + WS_ROWSS)}; small_gemm<8>((const bf16_t*)(ws + WS_CAT), 1024, 0, (const bf16_t*)(ws + WS_WT_OUT), 1024, SE, L); } }
    PH_SYNC(7);
    if (PH_ON(7)) { pg8::StaticOrder S; const bool sfirst = (blockIdx.x & 1) != 0;
        if (sfirst) { SEpiUG SE{(bf16_t*)(ws + WS_U), (bf16_t*)(ws + WS_SG), (const float*)(ws + WS_ROWSS)}; small_gemm<8>((const bf16_t*)(ws + WS_XN), 1024, 0, (const bf16_t*)(ws + WS_WT_INC), 2048, SE, L); }
        pg8::Gemm g{(const bf16_t*)(ws + WS_XN), (const bf16_t*)(ws + WS_WT_INC), MP, 2048, 1024, 1024, 0}; S.init(MP, 2048, gridDim.x, blockIdx.x);
        pg8::EpiUG E{(bf16_t*)(ws + WS_U), (bf16_t*)(ws + WS_SG), (const float*)(ws + WS_ROWSS)}; pg8::gemm_phase((LAS unsigned char*)lds, g, S, E);
        if (!sfirst) { SEpiUG SE{(bf16_t*)(ws + WS_U), (bf16_t*)(ws + WS_SG), (const float*)(ws + WS_ROWSS)}; small_gemm<8>((const bf16_t*)(ws + WS_XN), 1024, 0, (const bf16_t*)(ws + WS_WT_INC), 2048, SE, L); } }
    PH_SYNC(8);
    if (PH_ON(8)) for (int rep = 0; rep < PH_REP(8); ++rep) phase_pool(p);
    PH_SYNC(9);
    if (PH_ON(9)) { pg8::StaticOrder S; const bool sfirst = (blockIdx.x & 1) != 0;
        if (sfirst) { SEpiM SE{p.in[20], (const bf16_t*)(ws + WS_SG), (bf16_t*)(ws + WS_MM)}; small_gemm<2>((const bf16_t*)(ws + WS_POOL), 1024, 256, (const bf16_t*)(ws + WS_WT_GRP), 1024, SE, L); }
        pg8::Gemm g{(const bf16_t*)(ws + WS_POOL), (const bf16_t*)(ws + WS_WT_GRP), MP, 1024, 256, 1024, 512}; S.init(MP, 1024, gridDim.x, blockIdx.x);
        pg8::EpiM E{p.in[20], (const bf16_t*)(ws + WS_SG), (bf16_t*)(ws + WS_MM)}; pg8::gemm_phase((LAS unsigned char*)lds, g, S, E);
        if (!sfirst) { SEpiM SE{p.in[20], (const bf16_t*)(ws + WS_SG), (bf16_t*)(ws + WS_MM)}; small_gemm<2>((const bf16_t*)(ws + WS_POOL), 1024, 256, (const bf16_t*)(ws + WS_WT_GRP), 1024, SE, L); } }
    PH_SYNC(10);
    if (PH_ON(10)) { pg8::StaticOrder S; const bool sfirst = (blockIdx.x & 1) != 0;
        if (sfirst) { SEpiRes<false> SE{nullptr, p.out, (bf16_t*)(ws + WS_XN), nullptr, nullptr}; small_gemm<8>((const bf16_t*)(ws + WS_MM), 1024, 0, (const bf16_t*)(ws + WS_WT_OUTC), 1024, SE, L); }
        pg8::Gemm g{(const bf16_t*)(ws + WS_MM), (const bf16_t*)(ws + WS_WT_OUTC), MP, 1024, 1024, 1024, 0}; S.init(MP, 1024, gridDim.x, blockIdx.x);
        pg8::EpiRes<false> E{nullptr, nullptr, p.out, (bf16_t*)(ws + WS_XN), nullptr, nullptr}; pg8::gemm_phase((LAS unsigned char*)lds, g, S, E);
        if (!sfirst) { SEpiRes<false> SE{nullptr, p.out, (bf16_t*)(ws + WS_XN), nullptr, nullptr}; small_gemm<8>((const bf16_t*)(ws + WS_MM), 1024, 0, (const bf16_t*)(ws + WS_WT_OUTC), 1024, SE, L); } }
}

extern "C" void kernel_launch(void* const* d_in, const int* in_sizes, int n_in, void* d_out, int out_size, void* d_ws, size_t ws_size, hipStream_t stream) {
    constexpr int LDS_BYTES = pg8::STAGE_BYTES + 256;
    static int grid = 0;
    if (grid == 0) {
        if (n_in != 22 || ws_size < WS_END) { fprintf(stderr, "kernel_launch: unexpected n_in %d / ws_size %zu\n", n_in, ws_size); grid = -1; return; }
        int dev = 0, cus = 0, per_cu = 0;
        if (hipGetDevice(&dev) != hipSuccess || hipDeviceGetAttribute(&cus, hipDeviceAttributeMultiprocessorCount, dev) != hipSuccess) { grid = -1; return; }
        if (hipFuncSetAttribute((const void*)mega, hipFuncAttributeMaxDynamicSharedMemorySize, LDS_BYTES) != hipSuccess) { fprintf(stderr, "kernel_launch: hipFuncSetAttribute failed\n"); grid = -1; return; }
        if (hipOccupancyMaxActiveBlocksPerMultiprocessor(&per_cu, (const void*)mega, 512, LDS_BYTES) != hipSuccess || per_cu < 1) { fprintf(stderr, "kernel_launch: occupancy query says %d\n", per_cu); per_cu = 1; }
        (void)hipGetLastError();
        grid = cus;
    }
    if (grid < 0) return;
    if (hipMemsetAsync((char*)d_ws + WS_BAR, 0, XCD_BAR_WORDS * 4, stream) != hipSuccess) { fprintf(stderr, "kernel_launch: memset failed\n"); return; }
    Params p{};
    for (int i = 0; i < 22; ++i) p.in[i] = (const float*)d_in[i];
    p.out = (float*)d_out; p.ws = (unsigned char*)d_ws;
#if MK_LAUNCHES == 1
    p.ph_lo = 0; p.ph_hi = NPHASE;
    void* args[] = {&p};
    hipError_t e = hipLaunchCooperativeKernel((const void*)mega, dim3(grid), dim3(512), args, LDS_BYTES, stream);
    if (e != hipSuccess) fprintf(stderr, "cooperative launch failed: %s (grid %d)\n", hipGetErrorString(e), grid);
#else
    for (int ph = 0; ph < MK_STOP; ++ph) { p.ph_lo = ph; p.ph_hi = ph + 1; hipLaunchKernelGGL(mega, dim3(grid), dim3(512), LDS_BYTES, stream, p); }
#endif
}
```

```cpp
#include <hip/hip_runtime.h>
#include <hip/hip_cooperative_groups.h>
#include <cstdio>
namespace cg = cooperative_groups;

#ifndef MK_LAUNCHES
#define MK_LAUNCHES 1
#ifndef MK_STOP
#define MK_STOP 11
#endif
#endif

#define LAS __attribute__((address_space(3)))
typedef unsigned short bf16_t;
typedef short bf16x8 __attribute__((ext_vector_type(8)));
typedef short bf16x4 __attribute__((ext_vector_type(4)));
typedef float f32x4 __attribute__((ext_vector_type(4)));
typedef unsigned u32x4 __attribute__((ext_vector_type(4)));
typedef unsigned u32x2 __attribute__((ext_vector_type(2)));

constexpr int MP = 16384, MS = 512, MTOK = 16896, DM = 1024;
constexpr int NZ = 3328, LDWIN = 3336;
constexpr int ZC_AQ = 0, ZC_AK = 512, ZC_AV = 640, ZC_AG = 768, ZC_BQKV = 1280, ZC_BG = 2816;
constexpr int NCH = 1152;

constexpr size_t WS_WT_IN = 0, WS_WT_OUT = 6815744, WS_WT_INC = 8912896, WS_WT_GRP = 13107200, WS_WT_OUTC = 13631488,
                 WS_XN = 15728640, WS_Z = 50331648, WS_CAT = 162791424, WS_BA = 197394432, WS_SSQ = 197935104, WS_BAR = 200097792, WS_ROWSS = 200097792 + 16384, WS_END = 200181760 + 18874368 + 294912;
constexpr size_t WS_UT = 200181760, WS_GB = WS_UT + 18874368;
constexpr size_t WS_U = WS_Z, WS_SG = WS_Z + 69206016;
constexpr size_t WS_POOL = WS_Z + 34603008, WS_MM = WS_CAT;
constexpr size_t DN_W = 0, DN_QS = 18874368, DN_KT = 37748736, DN_QK = 56623104;

constexpr size_t O_Y = 0, O_PAK = 17301504, O_PAV = 17432576, O_PBS = 17563648, O_PBC = 18087936, O_PCP = 18124800,
                 O_SAK = 18247680, O_SAV = 18313216, O_SBS = 18378752, O_SBC = 20475904, O_SCP = 20623360;

struct Params {
    const float* in[22];
    float* out;
    unsigned char* ws;
    int ph_lo, ph_hi;
};

typedef __bf16 bf16v2_t __attribute__((ext_vector_type(2)));
typedef float f32v2_t __attribute__((ext_vector_type(2)));
__device__ __forceinline__ unsigned cvt_pk_bf16(float lo, float hi) { const f32v2_t v = {lo, hi}; const bf16v2_t r = __builtin_convertvector(v, bf16v2_t); return __builtin_bit_cast(unsigned, r); }
__device__ __forceinline__ bf16_t f2bf(float f) { return (bf16_t)(cvt_pk_bf16(f, 0.f) & 0xffffu); }
__device__ __forceinline__ float bf2f(short b) { return __uint_as_float(((unsigned)(unsigned short)b) << 16); }
__device__ __forceinline__ float silu_f(float x) { return x * __builtin_amdgcn_rcpf(1.0f + __expf(-x)); }
__device__ __forceinline__ bf16x8 pack8(const f32x4& a, const f32x4& b) {
    u32x4 w; w.x = cvt_pk_bf16(a[0], a[1]); w.y = cvt_pk_bf16(a[2], a[3]); w.z = cvt_pk_bf16(b[0], b[1]); w.w = cvt_pk_bf16(b[2], b[3]);
    return __builtin_bit_cast(bf16x8, w);
}
__device__ __forceinline__ bf16x8 cat8(const u32x2& a, const u32x2& b) { u32x4 w; w.x = a.x; w.y = a.y; w.z = b.x; w.w = b.y; return __builtin_bit_cast(bf16x8, w); }
__device__ __forceinline__ f32x4 mfma16(const bf16x8& a, const bf16x8& b, const f32x4& c) { return __builtin_amdgcn_mfma_f32_16x16x32_bf16(a, b, c, 0, 0, 0); }
template <int CTRL> __device__ __forceinline__ float dpp_f(float v) { return __builtin_bit_cast(float, __builtin_amdgcn_update_dpp(0, __builtin_bit_cast(int, v), CTRL, 0xF, 0xF, true)); }
__device__ __forceinline__ float sum8(float v) { v += dpp_f<0xB1>(v); v += dpp_f<0x4E>(v); v += dpp_f<0x141>(v); return v; }
__device__ __forceinline__ float sum16(float v) { v = sum8(v); v += dpp_f<0x140>(v); return v; }
__device__ __forceinline__ float wave_sum(float v) {
    v = sum16(v); v += __shfl_xor(v, 16); v += __shfl_xor(v, 32);
    return v;
}
__device__ __forceinline__ void lds_barrier() { asm volatile("s_waitcnt lgkmcnt(0)" ::: "memory"); __builtin_amdgcn_s_barrier(); asm volatile("" ::: "memory"); }
__device__ __forceinline__ int pos32(int x) { return ((x & 12) << 1) | ((x & 16) >> 2) | (x & 3); }

namespace pg8 {
constexpr int BM = 256, BK = 64, HALF = 128, HTB = HALF * BK * 2, STAGE_BYTES = 8 * HTB, NXCD = 8, WGM = 8;
__device__ __forceinline__ int lds_byte(int r, int c) { const int st = (r >> 4) * 2 + (c >> 5), rr = r & 15, cc = c & 31, ob = rr * 64 + cc * 2; return st * 1024 + (ob ^ (((ob >> 9) & 1) << 5)); }
__device__ __forceinline__ void stage_rc(int b, int& R, int& C) { const int st = b / 1024, sb = b % 1024, swz = sb ^ (((sb >> 9) & 1) << 5); R = (st >> 1) * 16 + swz / 64; C = (st & 1) * 32 + (swz % 64) / 2; }
__device__ __forceinline__ int perm32(int rho) { const int n = rho >> 4, i = rho & 15; return 8 * (i >> 2) + 4 * n + (i & 3); }
struct Unit { int pm, pn; };
struct Gemm { const bf16_t* A; const bf16_t* Bt; int M, N, K, lda, a_pn_step; };
struct StaticOrder {
    int nM, nN, nwg, G, c;
    __device__ void init(int M, int N, int G_, int c_) { nM = M / BM; nN = N / BM; nwg = nM * nN; G = G_; c = c_; }
    __device__ bool next(int i, Unit& u) const {
        const long L = (long)i * G + c; if (L >= nwg) return false;
        int wgid = (int)L; { const int q = nwg / NXCD, r = nwg % NXCD, xcd = wgid % NXCD, off = wgid / NXCD; wgid = (xcd < r ? xcd * (q + 1) : r * (q + 1) + (xcd - r) * q) + off; }
        const int nig = WGM * nN, gid = wgid / nig, fm = gid * WGM, gsz = (nM - fm) < WGM ? (nM - fm) : WGM;
        u.pm = fm + ((wgid % nig) % gsz); u.pn = (wgid % nig) / gsz; return true;
    }
};

template <class Epi>
__device__ __forceinline__ void gemm_phase(LAS unsigned char* lds, const Gemm g, const StaticOrder& S, const Epi& E) {
    const int tid = threadIdx.x, wid = __builtin_amdgcn_readfirstlane(tid >> 6), lane = tid & 63, wr = wid >> 2, wc = wid & 3, fr = lane & 15, fq = lane >> 4;
    const int K = g.K, nt = K / BK;
    unsigned voffA[2], voffB[2];
#pragma unroll
    for (int i = 0; i < 2; ++i) { int R, C; stage_rc(tid * 16 + i * 8192, R, C); const int Rb = Epi::PERM ? ((R & ~31) + perm32(R & 31)) : R;
        voffA[i] = (unsigned)(R * g.lda + C) * 2u; voffB[i] = (unsigned)(Rb * K + C) * 2u; }
    const size_t kstep = (size_t)(BK * 2);
    const size_t hstepA = (size_t)HALF * g.lda * 2, hstepB = (size_t)HALF * K * 2;
    const size_t tstepA = 2 * hstepA, tstepB = 2 * hstepB;
    const unsigned ldsw = (unsigned)wid * 1024u;
    const int aoff = lds_byte(wr * 64 + fr, fq * 8), boff = lds_byte(wc * 32 + fr, fq * 8);
#define PG8_SA(b, h) (((b) * 2 + (h)) * HTB)
#define PG8_SB(b, h) ((4 + (b) * 2 + (h)) * HTB)
#define PG8_STAGE(bufoff, gbase, voff) do { _Pragma("unroll") for (int _i = 0; _i < 2; ++_i) \
        __builtin_amdgcn_global_load_lds((const unsigned*)((const char*)(gbase) + (voff)[_i]), (LAS unsigned*)(lds + (bufoff) + ldsw + _i * 8192), 16, 0, 0); } while (0)
#define PG8_LDA(dst, b, h) do { _Pragma("unroll") for (int m = 0; m < 4; ++m) _Pragma("unroll") for (int k = 0; k < 2; ++k) dst[m][k] = *(const LAS bf16x8*)(lds + PG8_SA(b, h) + aoff + m * 2048 + k * 1024); } while (0)
#define PG8_LDB(dst, b, h) do { _Pragma("unroll") for (int n = 0; n < 2; ++n) _Pragma("unroll") for (int k = 0; k < 2; ++k) dst[n][k] = *(const LAS bf16x8*)(lds + PG8_SB(b, h) + boff + n * 2048 + k * 1024); } while (0)
#define PG8_MMA(ai, bj, At, Bt) do { __builtin_amdgcn_s_setprio(1); _Pragma("unroll") for (int m = 0; m < 4; ++m) _Pragma("unroll") for (int n = 0; n < 2; ++n) _Pragma("unroll") for (int k = 0; k < 2; ++k) \
        acc[ai][bj][m][n] = __builtin_amdgcn_mfma_f32_16x16x32_bf16(Bt[n][k], At[m][k], acc[ai][bj][m][n], 0, 0, 0); __builtin_amdgcn_s_setprio(0); } while (0)
#define PG8_WAIT_V(n) asm volatile("s_waitcnt vmcnt(" #n ")" ::: "memory")
#define PG8_WAIT_L(n) asm volatile("s_waitcnt lgkmcnt(" #n ")" ::: "memory")
#define PG8_BAR __builtin_amdgcn_s_barrier()
#define PG8_SCHED __builtin_amdgcn_sched_barrier(0)
    Unit cur, nxt; int ui = 0;
    if (!S.next(0, cur)) return;
    f32x4 acc[2][2][4][2];
#pragma unroll
    for (int a = 0; a < 2; ++a)
#pragma unroll
        for (int b = 0; b < 2; ++b)
#pragma unroll
            for (int m = 0; m < 4; ++m)
#pragma unroll
                for (int n = 0; n < 2; ++n) acc[a][b][m][n] = (f32x4){0.f, 0.f, 0.f, 0.f};
    bf16x8 At[4][2], B0[2][2], B1[2][2];
    const char* cA = (const char*)g.A + (size_t)cur.pm * tstepA + (size_t)cur.pn * g.a_pn_step; const char* cB = (const char*)g.Bt + (size_t)cur.pn * tstepB;
    PG8_STAGE(PG8_SB(0, 0), cB, voffB); PG8_STAGE(PG8_SA(0, 0), cA, voffA); PG8_STAGE(PG8_SB(0, 1), cB + hstepB, voffB); PG8_STAGE(PG8_SA(0, 1), cA + hstepA, voffA);
    if (wr == 1) PG8_BAR;
    PG8_WAIT_V(4); PG8_BAR;
    PG8_STAGE(PG8_SB(1, 0), cB + kstep, voffB); PG8_STAGE(PG8_SA(1, 0), cA + kstep, voffA); PG8_STAGE(PG8_SB(1, 1), cB + hstepB + kstep, voffB);
    PG8_WAIT_V(6); PG8_BAR;
    for (;;) {
        const bool has_next = S.next(ui + 1, nxt);
        const char* nA = has_next ? (const char*)g.A + (size_t)nxt.pm * tstepA + (size_t)nxt.pn * g.a_pn_step : cA; const char* nB = has_next ? (const char*)g.Bt + (size_t)nxt.pn * tstepB : cB;
#pragma unroll 1
        for (int t = 0; t < nt; t += 2) {
            const bool last = (t == nt - 2);
            const char* a1 = cA + (size_t)(t + 1) * kstep;
            const char* a2 = last ? nA : cA + (size_t)(t + 2) * kstep; const char* b2 = last ? nB : cB + (size_t)(t + 2) * kstep;
            const char* a3 = a2 + kstep; const char* b3 = b2 + kstep;
            PG8_LDB(B0, 0, 0); PG8_SCHED; PG8_LDA(At, 0, 0); PG8_STAGE(PG8_SA(1, 1), a1 + hstepA, voffA);
            PG8_WAIT_L(8); PG8_BAR; PG8_WAIT_L(0); PG8_MMA(0, 0, At, B0); PG8_BAR; PG8_SCHED;
            PG8_LDB(B1, 0, 1); PG8_STAGE(PG8_SB(0, 0), b2, voffB);
            PG8_BAR; PG8_WAIT_L(0); PG8_MMA(0, 1, At, B1); PG8_BAR;
            PG8_LDA(At, 0, 1); PG8_STAGE(PG8_SA(0, 0), a2, voffA);
            PG8_BAR; PG8_WAIT_L(0); PG8_MMA(1, 0, At, B0); PG8_BAR; PG8_SCHED;
            PG8_STAGE(PG8_SB(0, 1), b2 + hstepB, voffB);
            PG8_WAIT_V(6); PG8_BAR; PG8_MMA(1, 1, At, B1); PG8_BAR;
            PG8_LDB(B0, 1, 0); PG8_SCHED; PG8_LDA(At, 1, 0); PG8_STAGE(PG8_SA(0, 1), a2 + hstepA, voffA);
            PG8_WAIT_L(8); PG8_BAR; PG8_WAIT_L(0); PG8_MMA(0, 0, At, B0); PG8_BAR; PG8_SCHED;
            PG8_LDB(B1, 1, 1); PG8_STAGE(PG8_SB(1, 0), b3, voffB);
            PG8_BAR; PG8_WAIT_L(0); PG8_MMA(0, 1, At, B1); PG8_BAR;
            PG8_LDA(At, 1, 1); PG8_STAGE(PG8_SA(1, 0), a3, voffA);
            PG8_BAR; PG8_WAIT_L(0); PG8_MMA(1, 0, At, B0); PG8_BAR; PG8_SCHED;
            PG8_STAGE(PG8_SB(1, 1), b3 + hstepB, voffB);
            PG8_WAIT_V(6); PG8_BAR; PG8_MMA(1, 1, At, B1); PG8_BAR;
        }
        E(acc, cur, wr, wc, fr, fq);
        if (!has_next) break;
#pragma unroll
        for (int a = 0; a < 2; ++a)
#pragma unroll
            for (int b = 0; b < 2; ++b)
#pragma unroll
                for (int m = 0; m < 4; ++m)
#pragma unroll
                    for (int n = 0; n < 2; ++n) acc[a][b][m][n] = (f32x4){0.f, 0.f, 0.f, 0.f};
        cur = nxt; cA = nA; cB = nB; ++ui;
    }
    PG8_WAIT_V(0);
    if (wr == 0) PG8_BAR;
    PG8_BAR;
#undef PG8_SA
#undef PG8_SB
#undef PG8_STAGE
#undef PG8_LDA
#undef PG8_LDB
#undef PG8_MMA
#undef PG8_WAIT_V
#undef PG8_WAIT_L
#undef PG8_BAR
#undef PG8_SCHED
}

struct EpiZ {
    static constexpr bool PERM = true;
    bf16_t* O; int ldc;
    __device__ __forceinline__ void operator()(const f32x4 (&acc)[2][2][4][2], const Unit& u, int wr, int wc, int fr, int fq) const {
        const int row0 = u.pm * BM + wr * 64 + fr, col0 = u.pn * BM + wc * 32 + 8 * fq;
#pragma unroll
        for (int ai = 0; ai < 2; ++ai)
#pragma unroll
            for (int m = 0; m < 4; ++m) { bf16_t* rowp = O + (size_t)(row0 + ai * HALF + m * 16) * ldc + col0;
#pragma unroll
                for (int bj = 0; bj < 2; ++bj) { const f32x4 v0 = acc[ai][bj][m][0], v1 = acc[ai][bj][m][1];
                    u32x4 w; w.x = cvt_pk_bf16(v0[0], v0[1]); w.y = cvt_pk_bf16(v0[2], v0[3]); w.z = cvt_pk_bf16(v1[0], v1[1]); w.w = cvt_pk_bf16(v1[2], v1[3]);
                    *(u32x4*)(rowp + bj * HALF) = w; } }
    }
};
template <bool NORM> struct EpiRes {
    static constexpr bool PERM = false;
    const float* base0; const float* base1; float* out; bf16_t* a3; const float* gvec; float* rowss;
    __device__ __forceinline__ void operator()(const f32x4 (&acc)[2][2][4][2], const Unit& u, int wr, int wc, int fr, int fq) const {
        const int row0 = u.pm * BM + wr * 64 + fr, col0 = u.pn * BM + wc * 32 + 4 * fq;
        const float* bb = (u.pm < 64) ? base0 : base1 - (size_t)MP * DM;
#pragma unroll
        for (int ai = 0; ai < 2; ++ai)
#pragma unroll
            for (int m = 0; m < 4; ++m) { const size_t ro = (size_t)(row0 + ai * HALF + m * 16) * DM + col0; float ss = 0.f;
#pragma unroll
                for (int bj = 0; bj < 2; ++bj)
#pragma unroll
                    for (int n = 0; n < 2; ++n) {
                        if constexpr (NORM) {
                            const f32x4 bv = *(const f32x4*)(bb + ro + bj * HALF + n * 16); const f32x4 v = acc[ai][bj][m][n] + bv;
                            ss += (v[0] * v[0] + v[1] * v[1]) + (v[2] * v[2] + v[3] * v[3]);
                            u32x2 w; w.x = cvt_pk_bf16(v[0], v[1]); w.y = cvt_pk_bf16(v[2], v[3]); *(u32x2*)(a3 + ro + bj * HALF + n * 16) = w;
                        } else {
                            const bf16x4 hb = *(const bf16x4*)(a3 + ro + bj * HALF + n * 16);
                            *(f32x4*)(out + ro + bj * HALF + n * 16) = acc[ai][bj][m][n] + (f32x4){bf2f(hb[0]), bf2f(hb[1]), bf2f(hb[2]), bf2f(hb[3])}; } }
                if constexpr (NORM) { ss += __shfl_xor(ss, 16); ss += __shfl_xor(ss, 32); if (fq == 0) atomicAdd(rowss + row0 + ai * HALF + m * 16, ss); } }
    }
};
struct EpiUG {
    static constexpr bool PERM = true;
    bf16_t* U; bf16_t* SG; const float* rowss;
    __device__ __forceinline__ void operator()(const f32x4 (&acc)[2][2][4][2], const Unit& u, int wr, int wc, int fr, int fq) const {
        const int row0 = u.pm * BM + wr * 64 + fr, col0 = (u.pn & 3) * BM + wc * 32 + 8 * fq;
        const bool isu = u.pn < 4;
#pragma unroll
        for (int ai = 0; ai < 2; ++ai)
#pragma unroll
            for (int m = 0; m < 4; ++m) { const size_t ro = (size_t)(row0 + ai * HALF + m * 16) * DM + col0;
                const float rr = rsqrtf(rowss[row0 + ai * HALF + m * 16] * (1.0f / 1024.0f) + 1e-6f);
#pragma unroll
                for (int bj = 0; bj < 2; ++bj) { const f32x4 v0 = acc[ai][bj][m][0] * rr, v1 = acc[ai][bj][m][1] * rr;
                    if (isu) { u32x4 w; w.x = cvt_pk_bf16(v0[0], v0[1]); w.y = cvt_pk_bf16(v0[2], v0[3]); w.z = cvt_pk_bf16(v1[0], v1[1]); w.w = cvt_pk_bf16(v1[2], v1[3]); *(u32x4*)(U + ro + bj * HALF) = w; }
                    else { u32x4 w; w.x = cvt_pk_bf16(silu_f(v0[0]), silu_f(v0[1])); w.y = cvt_pk_bf16(silu_f(v0[2]), silu_f(v0[3]));
                           w.z = cvt_pk_bf16(silu_f(v1[0]), silu_f(v1[1])); w.w = cvt_pk_bf16(silu_f(v1[2]), silu_f(v1[3]));
                           *(u32x4*)(SG + ro + bj * HALF) = w; } } }
    }
};
struct EpiM {
    static constexpr bool PERM = true;
    const float* scale; const bf16_t* SG; bf16_t* O;
    __device__ __forceinline__ void operator()(const f32x4 (&acc)[2][2][4][2], const Unit& u, int wr, int wc, int fr, int fq) const {
        const int row0 = u.pm * BM + wr * 64 + fr, col0 = u.pn * BM + wc * 32 + 8 * fq;
#pragma unroll
        for (int ai = 0; ai < 2; ++ai)
#pragma unroll
            for (int m = 0; m < 4; ++m) { const size_t ro = (size_t)(row0 + ai * HALF + m * 16) * DM + col0;
#pragma unroll
                for (int bj = 0; bj < 2; ++bj) { const bf16x8 gv = *(const bf16x8*)(SG + ro + bj * HALF);
                    const f32x4 v0 = acc[ai][bj][m][0] * *(const f32x4*)(scale + col0 + bj * HALF), v1 = acc[ai][bj][m][1] * *(const f32x4*)(scale + col0 + bj * HALF + 4);
                    u32x4 w; w.x = cvt_pk_bf16(v0[0] * bf2f(gv[0]), v0[1] * bf2f(gv[1])); w.y = cvt_pk_bf16(v0[2] * bf2f(gv[2]), v0[3] * bf2f(gv[3]));
                    w.z = cvt_pk_bf16(v1[0] * bf2f(gv[4]), v1[1] * bf2f(gv[5])); w.w = cvt_pk_bf16(v1[2] * bf2f(gv[6]), v1[3] * bf2f(gv[7]));
                    *(u32x4*)(O + ro + bj * HALF) = w; } }
    }
};
}

__device__ __forceinline__ void transpose_tile(const float* __restrict__ src, int ld, bf16_t* __restrict__ dst, int K, int k0, int n0, LAS float* tile, const float* __restrict__ kscale) {
    const int tid = threadIdx.x;
#pragma unroll
    for (int i = 0; i < 2; ++i) {
        const int k = (tid >> 4) + 32 * i, n4 = (tid & 15) * 4;
        const float4 v = *(const float4*)(src + (size_t)(k0 + k) * ld + n0 + n4);
        const float ks = kscale ? kscale[k0 + k] : 1.0f;
        LAS float* tp = tile + k * 65 + n4; tp[0] = v.x * ks; tp[1] = v.y * ks; tp[2] = v.z * ks; tp[3] = v.w * ks;
    }
    __syncthreads();
    const int n = tid >> 3, k8 = (tid & 7) * 8;
    float f[8];
#pragma unroll
    for (int j = 0; j < 8; ++j) f[j] = tile[(k8 + j) * 65 + n];
    u32x4 w; w.x = cvt_pk_bf16(f[0], f[1]); w.y = cvt_pk_bf16(f[2], f[3]); w.z = cvt_pk_bf16(f[4], f[5]); w.w = cvt_pk_bf16(f[6], f[7]);
    *(u32x4*)(dst + (size_t)(n0 + n) * K + k0 + k8) = w;
    __syncthreads();
}

template <bool EXTRA>
__device__ __forceinline__ void rmsnorm_rows(const float* __restrict__ x0, const float* __restrict__ x1, const float* __restrict__ g,
                                             const float* __restrict__ wex, bf16_t* __restrict__ xn, float* __restrict__ ba, LAS f32x4* slab) {
    const int lane = threadIdx.x & 63, wid = threadIdx.x >> 6;
    const int gw = blockIdx.x * 8 + wid, nw = gridDim.x * 8;
    float4 gg[4];
#pragma unroll
    for (int i = 0; i < 4; ++i) gg[i] = *(const float4*)(g + lane * 4 + 256 * i);
    if constexpr (EXTRA) {
        for (int idx = threadIdx.x; idx < 2048; idx += 512) { const int k = idx >> 1, half = idx & 1, ln = (k & 255) >> 2, i = k >> 8, e = k & 3;
            slab[((i * 4 + e) * 2 + half) * 64 + ln] = *(const f32x4*)(wex + (size_t)k * LDWIN + half * 4); }
        __syncthreads();
    }
    float4 vn_[4];
    if (gw < MTOK) { const float* x = gw < MP ? x0 + (size_t)gw * DM : x1 + (size_t)(gw - MP) * DM;
#pragma unroll
        for (int i = 0; i < 4; ++i) vn_[i] = *(const float4*)(x + lane * 4 + 256 * i); }
    for (int row = gw; row < MTOK; row += nw) {
        float4 v[4]; float ss = 0.f;
#pragma unroll
        for (int i = 0; i < 4; ++i) v[i] = vn_[i];
        { const int rn = (row + nw < MTOK) ? row + nw : row;
          const float* xn_ = rn < MP ? x0 + (size_t)rn * DM : x1 + (size_t)(rn - MP) * DM;
#pragma unroll
          for (int i = 0; i < 4; ++i) vn_[i] = *(const float4*)(xn_ + lane * 4 + 256 * i); }
#pragma unroll
        for (int i = 0; i < 4; ++i) ss += v[i].x * v[i].x + v[i].y * v[i].y + v[i].z * v[i].z + v[i].w * v[i].w;
        ss = wave_sum(ss);
        const float r = rsqrtf(ss * (1.0f / 1024.0f) + 1e-6f);
        float a[8] = {0.f, 0.f, 0.f, 0.f, 0.f, 0.f, 0.f, 0.f};
#pragma unroll
        for (int i = 0; i < 4; ++i) {
            float y[4] = {v[i].x * r * gg[i].x, v[i].y * r * gg[i].y, v[i].z * r * gg[i].z, v[i].w * r * gg[i].w};
            u32x2 w; w.x = cvt_pk_bf16(y[0], y[1]); w.y = cvt_pk_bf16(y[2], y[3]);
            *(u32x2*)(xn + (size_t)row * DM + lane * 4 + 256 * i) = w;
            if constexpr (EXTRA) {
#pragma unroll
                for (int e = 0; e < 4; ++e) { const f32x4 w0 = slab[((i * 4 + e) * 2) * 64 + lane], w1 = slab[((i * 4 + e) * 2 + 1) * 64 + lane];
                    a[0] += y[e] * w0.x; a[1] += y[e] * w0.y; a[2] += y[e] * w0.z; a[3] += y[e] * w0.w;
                    a[4] += y[e] * w1.x; a[5] += y[e] * w1.y; a[6] += y[e] * w1.z; a[7] += y[e] * w1.w; }
            }
        }
        if constexpr (EXTRA) {
#pragma unroll
            for (int j = 0; j < 8; ++j) a[j] = wave_sum(a[j]);
            if (lane == 0) { *(float4*)(ba + (size_t)row * 8) = make_float4(a[0], a[1], a[2], a[3]); *(float4*)(ba + (size_t)row * 8 + 4) = make_float4(a[4], a[5], a[6], a[7]); }
        }
    }
}

__device__ __forceinline__ void phase_prep(const Params& p, LAS unsigned char* lds) {
    LAS float* tile = (LAS float*)lds;
    unsigned char* ws = p.ws;
    for (int t = blockIdx.x; t < 1920; t += gridDim.x) {
        const float* src; int ld, K, kt, nt_; bf16_t* dst; const float* ksc = nullptr;
        if (t < 832) { src = p.in[8]; ld = LDWIN; K = 1024; dst = (bf16_t*)(ws + WS_WT_IN); kt = t / 52; nt_ = t % 52; }
        else if (t < 1088) { const int t2 = t - 832; src = p.in[16]; ld = 1024; K = 1024; dst = (bf16_t*)(ws + WS_WT_OUT); kt = t2 >> 4; nt_ = t2 & 15; }
        else if (t < 1600) { const int t2 = t - 1088; src = p.in[18]; ld = 2048; K = 1024; dst = (bf16_t*)(ws + WS_WT_INC); ksc = p.in[17]; kt = t2 >> 5; nt_ = t2 & 31; }
        else if (t < 1664) { const int t2 = t - 1600, gq = t2 >> 4; src = p.in[19] + gq * 65536; ld = 256; K = 256; dst = (bf16_t*)(ws + WS_WT_GRP) + gq * 65536; kt = (t2 & 15) >> 2; nt_ = t2 & 3; }
        else { const int t2 = t - 1664; src = p.in[21]; ld = 1024; K = 1024; dst = (bf16_t*)(ws + WS_WT_OUTC); kt = t2 >> 4; nt_ = t2 & 15; }
        transpose_tile(src, ld, dst, K, kt * 64, nt_ * 64, tile, ksc);
    }
    { float* rs = (float*)(ws + WS_ROWSS); for (int i = blockIdx.x * 512 + threadIdx.x; i < MTOK; i += gridDim.x * 512) rs[i] = 0.f; }
    rmsnorm_rows<true>(p.in[0], p.in[1], p.in[7], p.in[8] + NZ, (bf16_t*)(ws + WS_XN), (float*)(ws + WS_BA), (LAS f32x4*)(lds + 32768));
}

constexpr int L_QS = 0, L_KS = 17408, L_KT = 34816, L_VT = 53248, L_AS = 71680, L_TU = 89088, L_TW = 98304, L_BG = 107520;

__device__ __forceinline__ void dn_prep(const Params& p, LAS unsigned char* lds) {
    const int tid = threadIdx.x, lane = tid & 63, wid = tid >> 6, fr = lane & 15, fq = lane >> 4;
    LAS bf16_t* Qs = (LAS bf16_t*)(lds + L_QS); LAS bf16_t* Ks = (LAS bf16_t*)(lds + L_KS); LAS bf16_t* Kts = (LAS bf16_t*)(lds + L_KT); LAS bf16_t* Vts = (LAS bf16_t*)(lds + L_VT);
    LAS float* As = (LAS float*)(lds + L_AS); LAS bf16_t* Tu = (LAS bf16_t*)(lds + L_TU); LAS bf16_t* Tw = (LAS bf16_t*)(lds + L_TW);
    LAS float* beta_s = (LAS float*)(lds + L_BG); LAS float* G_s = beta_s + 64;
    const bf16_t* Z = (const bf16_t*)(p.ws + WS_Z);
    const float* BA = (const float*)(p.ws + WS_BA);
    unsigned char* dn = (unsigned char*)p.out;
    LAS float* cw_s = (LAS float*)(lds + 108032);
    int hb = -1;
    for (int ci = blockIdx.x; ci < NCH; ci += gridDim.x) {
        const bool samp = ci >= 1024;
        if ((ci & 3) != hb) { hb = ci & 3;
            lds_barrier();
            for (int idx = tid; idx < 1536; idx += 512) { const int j = idx / 384, r = idx - j * 384; cw_s[idx] = p.in[12][j * 1536 + (r >> 7) * 512 + hb * 128 + (r & 127)]; }
            lds_barrier(); }
        int b, n, h, chs, row0, ntok;
        if (!samp) { h = ci & 3; n = (ci >> 2) & 31; b = ci >> 7; chs = ((b * 4 + h) << 5) + n; row0 = b * 2048 + n * 64; ntok = 64; }
        else { const int s = ci - 1024; h = s & 3; b = s >> 2; n = 0; chs = 1024 + s; row0 = MP + b * 16; ntok = 16; }
        bf16_t* gW = (bf16_t*)(dn + DN_W) + (size_t)chs * 8192; bf16_t* gQS = (bf16_t*)(dn + DN_QS) + (size_t)chs * 8192;
        bf16_t* gKT = (bf16_t*)(dn + DN_KT) + (size_t)chs * 8192; bf16_t* gQK = (bf16_t*)(dn + DN_QK) + (size_t)chs * 4096;
        bf16_t* gUT = (bf16_t*)(p.ws + WS_UT) + (size_t)chs * 8192; float* gG = (float*)(p.ws + WS_GB) + (size_t)chs * 64;
        if (wid == 0) {
            const bool valid = lane < ntok;
            float be = 0.f, gl = 0.f;
            if (valid) {
                const float bl = BA[(size_t)(row0 + lane) * 8 + h], al = BA[(size_t)(row0 + lane) * 8 + 4 + h] + p.in[14][h];
                be = __builtin_amdgcn_rcpf(1.0f + __expf(-bl));
                const float sp = al > 20.f ? al : log1pf(__expf(al));
                gl = -__expf(p.in[13][h]) * sp;
            }
#pragma unroll
            for (int o = 1; o < 64; o <<= 1) { const float t = __shfl_up(gl, o); if (lane >= o) gl += t; }
            beta_s[lane] = be; G_s[lane] = gl; gG[lane] = gl;
        }
        {
            int z2; asm volatile("v_mov_b32 %0, 0" : "=v"(z2));
            const int tid2 = tid + z2;
            const int t = tid2 >> 3, sub = tid2 & 7, d0 = sub * 16;
            const bool valid = t < ntok;
            const bool whist = valid && (samp || n == 31) && (t >= ntok - 3);
            float* hist_out = p.out + (samp ? O_SBC : O_PBC) + (size_t)(b * 3 + (t - (ntok - 3))) * 1536;
#pragma unroll
            for (int part = 0; part < 3; ++part) {
                bf16x8 raw[4][2];
#pragma unroll
                for (int j = 0; j < 4; ++j) { const int tt = t - 3 + j; int te = (tt >= 0 || (!samp && n > 0)) ? tt : 0; te = te < ntok ? te : ntok - 1;
                    const bf16_t* zp = Z + (size_t)(row0 + te) * NZ + ZC_BQKV + part * 512 + h * 128 + d0;
                    raw[j][0] = *(const bf16x8*)zp; raw[j][1] = *(const bf16x8*)(zp + 8); }
                const int c0 = part * 512 + h * 128 + d0;
                float y[16];
#pragma unroll
                for (int e = 0; e < 16; ++e) y[e] = 0.f;
#pragma unroll
                for (int j = 0; j < 4; ++j) {
                    const int tt = t - 3 + j;
                    float xv[16];
                    if (valid && (tt >= 0 || (!samp && n > 0))) {
#pragma unroll
                        for (int e = 0; e < 8; ++e) { xv[e] = bf2f(raw[j][0][e]); xv[8 + e] = bf2f(raw[j][1][e]); }
                    } else if (valid && samp) {
                        const float* hp = p.in[5] + (size_t)(b * 3 + (3 + tt)) * 1536 + c0;
#pragma unroll
                        for (int e4 = 0; e4 < 4; ++e4) { const float4 q4 = *(const float4*)(hp + e4 * 4); xv[e4 * 4] = q4.x; xv[e4 * 4 + 1] = q4.y; xv[e4 * 4 + 2] = q4.z; xv[e4 * 4 + 3] = q4.w; }
                    } else {
#pragma unroll
                        for (int e = 0; e < 16; ++e) xv[e] = 0.f;
                    }
                    const LAS float* cw = cw_s + j * 384 + part * 128 + d0;
#pragma unroll
                    for (int e4 = 0; e4 < 4; ++e4) { const f32x4 c4 = *(const LAS f32x4*)(cw + e4 * 4);
                        y[e4 * 4] += xv[e4 * 4] * c4[0]; y[e4 * 4 + 1] += xv[e4 * 4 + 1] * c4[1]; y[e4 * 4 + 2] += xv[e4 * 4 + 2] * c4[2]; y[e4 * 4 + 3] += xv[e4 * 4 + 3] * c4[3]; }
                    if (j == 3 && whist) {
#pragma unroll
                        for (int e4 = 0; e4 < 4; ++e4) *(float4*)(hist_out + c0 + e4 * 4) = make_float4(xv[e4 * 4], xv[e4 * 4 + 1], xv[e4 * 4 + 2], xv[e4 * 4 + 3]);
                    }
                }
                float ss = 0.f;
#pragma unroll
                for (int e = 0; e < 16; ++e) { y[e] = valid ? silu_f(y[e]) : 0.f; ss += y[e] * y[e]; }
                ss = sum8(ss);
                if (part < 2) { const float r = rsqrtf(ss + 1e-6f) * (part == 0 ? 0.08838834764831845f : 1.0f);
#pragma unroll
                    for (int e = 0; e < 16; ++e) y[e] *= r; }
                u32x4 w0, w1;
                w0.x = cvt_pk_bf16(y[0], y[1]); w0.y = cvt_pk_bf16(y[2], y[3]); w0.z = cvt_pk_bf16(y[4], y[5]); w0.w = cvt_pk_bf16(y[6], y[7]);
                w1.x = cvt_pk_bf16(y[8], y[9]); w1.y = cvt_pk_bf16(y[10], y[11]); w1.z = cvt_pk_bf16(y[12], y[13]); w1.w = cvt_pk_bf16(y[14], y[15]);
                if (part == 0) {
                    *(LAS u32x4*)(Qs + t * 136 + d0) = w0; *(LAS u32x4*)(Qs + t * 136 + d0 + 8) = w1;
                    bf16_t* qp = gQS + t * 128 + 32 * (sub >> 1) + 4 * (sub & 1);
                    *(u32x2*)(qp) = (u32x2){w0.x, w0.y}; *(u32x2*)(qp + 8) = (u32x2){w0.z, w0.w}; *(u32x2*)(qp + 16) = (u32x2){w1.x, w1.y}; *(u32x2*)(qp + 24) = (u32x2){w1.z, w1.w};
                } else if (part == 1) {
                    *(LAS u32x4*)(Ks + t * 136 + d0) = w0; *(LAS u32x4*)(Ks + t * 136 + d0 + 8) = w1;
#pragma unroll
                    for (int e = 0; e < 16; ++e) Kts[(d0 + e) * 72 + (t ^ (8 * sub))] = f2bf(y[e]);
                } else {
#pragma unroll
                    for (int e = 0; e < 16; ++e) Vts[(d0 + e) * 72 + (t ^ (8 * sub))] = f2bf(y[e]);
                }
            }
        }
        lds_barrier();
        {
            const int sel = wid >> 2, ti = wid & 3;
            int z3; asm volatile("v_mov_b32 %0, 0" : "=v"(z3));
            const int fr = ((tid + z3) & 15), fq = ((tid + z3) & 63) >> 4;
#pragma unroll
            for (int tj = 0; tj < 4; ++tj) {
                if (sel == 0) {
                    if (tj <= ti) {
                        f32x4 acc = {0.f, 0.f, 0.f, 0.f};
#pragma unroll
                        for (int kk = 0; kk < 4; ++kk) { const bf16x8 a = *(const LAS bf16x8*)(Ks + (16 * ti + fr) * 136 + kk * 32 + 8 * fq), bb = *(const LAS bf16x8*)(Ks + (16 * tj + fr) * 136 + kk * 32 + 8 * fq); acc = mfma16(a, bb, acc); }
                        const int j = 16 * tj + fr; const float Gj = G_s[j];
#pragma unroll
                        for (int jj = 0; jj < 4; ++jj) { const int i = 16 * ti + 4 * fq + jj;
                            As[i * 68 + j] = (i > j) ? beta_s[i] * acc[jj] * __expf(G_s[i] - Gj) : 0.f; }
                    }
                } else {
                    f32x4 acc = {0.f, 0.f, 0.f, 0.f};
                    if (tj <= ti) {
#pragma unroll
                        for (int kk = 0; kk < 4; ++kk) { const bf16x8 a = *(const LAS bf16x8*)(Ks + (16 * tj + fr) * 136 + kk * 32 + 8 * fq), bb = *(const LAS bf16x8*)(Qs + (16 * ti + fr) * 136 + kk * 32 + 8 * fq); acc = mfma16(a, bb, acc); }
                    }
                    const int i = 16 * ti + fr; const float Gi = G_s[i];
                    float v[4];
#pragma unroll
                    for (int jj = 0; jj < 4; ++jj) { const int j = 16 * tj + 4 * fq + jj; v[jj] = (i >= j) ? acc[jj] * __expf(Gi - G_s[j]) : 0.f; }
                    u32x2 w; w.x = cvt_pk_bf16(v[0], v[1]); w.y = cvt_pk_bf16(v[2], v[3]);
                    *(u32x2*)(gQK + i * 64 + 32 * (tj >> 1) + 8 * fq + 4 * (tj & 1)) = w;
                }
            }
        }
        lds_barrier();
        if (wid == 0 && samp) {
            float T[16];
            int zoff; asm volatile("v_mov_b32 %0, 0" : "=v"(zoff));
            const LAS float* Asz = As + zoff;
            const float bc = beta_s[lane], wcf = bc * __expf(G_s[lane]);
            int lo2 = lane; asm volatile("" : "+v"(lo2));
            LAS bf16_t* tub = Tu + lo2; LAS bf16_t* twb = Tw + lo2;
#pragma unroll
            for (int i = 0; i < 16; ++i) {
                float a0 = (lane == i) ? 1.f : 0.f, a1 = 0.f;
#pragma unroll
                for (int j4 = 0; j4 < (i + 3) / 4; ++j4) {
                    const f32x4 av = *(const LAS f32x4*)(Asz + i * 68 + j4 * 4);
#pragma unroll
                    for (int e = 0; e < 4; ++e) { const int jx = j4 * 4 + e; if (jx < i) { if (jx & 1) a1 -= av[e] * T[jx]; else a0 -= av[e] * T[jx]; } }
                }
                T[i] = a0 + a1;
                tub[i * 72] = f2bf(T[i] * bc); twb[i * 72] = f2bf(T[i] * wcf);
            }
#pragma unroll
            for (int i = 16; i < 64; ++i) { tub[i * 72] = 0; twb[i * 72] = 0; }
        } else
        if (wid == 0) {
            float T[64];
            int zoff; asm volatile("v_mov_b32 %0, 0" : "=v"(zoff));
            const LAS float* Asz = As + zoff;
            const float bc = beta_s[lane], wcf = bc * __expf(G_s[lane]);
            int lo2 = lane; asm volatile("" : "+v"(lo2));
            LAS bf16_t* tub = Tu + lo2; LAS bf16_t* twb = Tw + lo2;
            f32x4 rlo[2][8], rhi[8];
            T[0] = (lane == 0) ? 1.f : 0.f;
            tub[0] = f2bf(T[0] * bc); twb[0] = f2bf(T[0] * wcf);
            rlo[1][0] = *(const LAS f32x4*)(Asz + 68);
#pragma unroll
            for (int i = 1; i < 64; ++i) {
#pragma unroll
                for (int j4 = 8; j4 < (i + 3) / 4; ++j4) rhi[j4 - 8] = *(const LAS f32x4*)(Asz + i * 68 + j4 * 4);
                if (i + 1 < 64) {
#pragma unroll
                    for (int j4 = 0; j4 < ((i + 4) / 4 < 8 ? (i + 4) / 4 : 8); ++j4) rlo[(i + 1) & 1][j4] = *(const LAS f32x4*)(Asz + (i + 1) * 68 + j4 * 4);
                }
                float a0 = (lane == i) ? 1.f : 0.f, a1 = 0.f, a2 = 0.f, a3 = 0.f;
#pragma unroll
                for (int j4 = 0; j4 < (i + 3) / 4; ++j4) {
                    const f32x4 av = (j4 < 8) ? rlo[i & 1][j4 & 7] : rhi[(j4 - 8) & 7];
                    if (j4 * 4 + 0 < i) a0 -= av[0] * T[j4 * 4 + 0];
                    if (j4 * 4 + 1 < i) a1 -= av[1] * T[j4 * 4 + 1];
                    if (j4 * 4 + 2 < i) a2 -= av[2] * T[j4 * 4 + 2];
                    if (j4 * 4 + 3 < i) a3 -= av[3] * T[j4 * 4 + 3];
                }
                T[i] = (a0 + a1) + (a2 + a3);
                tub[i * 72] = f2bf(T[i] * bc); twb[i * 72] = f2bf(T[i] * wcf);
                __builtin_amdgcn_sched_barrier(0);
            }
        }
        lds_barrier();
        {
            const int td = wid;
            int z5; asm volatile("v_mov_b32 %0, 0" : "=v"(z5));
            const int fr = ((tid + z5) & 15), fq = ((tid + z5) & 63) >> 4;
#pragma unroll
            for (int tt = 0; tt < 4; ++tt) {
                f32x4 au = {0.f, 0.f, 0.f, 0.f}, aw = {0.f, 0.f, 0.f, 0.f};
#pragma unroll
                for (int kk = 0; kk < 2; ++kk) {
                    const bf16x8 tu = *(const LAS bf16x8*)(Tu + (16 * tt + fr) * 72 + kk * 32 + 8 * fq), vt = *(const LAS bf16x8*)(Vts + (16 * td + fr) * 72 + ((kk * 32 + 8 * fq) ^ (8 * td)));
                    au = mfma16(tu, vt, au);
                    const bf16x8 kt = *(const LAS bf16x8*)(Kts + (16 * td + fr) * 72 + ((kk * 32 + 8 * fq) ^ (8 * td))), tw = *(const LAS bf16x8*)(Tw + (16 * tt + fr) * 72 + kk * 32 + 8 * fq);
                    aw = mfma16(kt, tw, aw);
                }
                u32x2 wu; wu.x = cvt_pk_bf16(au[0], au[1]); wu.y = cvt_pk_bf16(au[2], au[3]);
                *(u32x2*)(gUT + (16 * td + fr) * 64 + 16 * tt + 4 * fq) = wu;
                u32x2 ww; ww.x = cvt_pk_bf16(aw[0], aw[1]); ww.y = cvt_pk_bf16(aw[2], aw[3]);
                *(u32x2*)(gW + (16 * tt + fr) * 128 + 32 * (td >> 1) + 8 * fq + 4 * (td & 1)) = ww;
            }
#pragma unroll
            for (int q = tid + z5; q < 1024; q += 512) { const int dk = q >> 3, c8 = q & 7, u = c8 >> 2, f = c8 & 3;
                const int sw = 8 * ((dk >> 4) & 7);
                const u32x2 lo = *(const LAS u32x2*)(Kts + dk * 72 + ((32 * u + 4 * f) ^ sw)), hi = *(const LAS u32x2*)(Kts + dk * 72 + ((32 * u + 16 + 4 * f) ^ sw));
                *(u32x4*)(gKT + dk * 64 + 8 * c8) = (u32x4){lo.x, lo.y, hi.x, hi.y}; }
        }
        lds_barrier();
    }
}

__device__ __forceinline__ void attn_items(const Params& p, LAS unsigned char* lds, int ai0, int aistride) {
    const int tid = threadIdx.x, lane = tid & 63, wid = tid >> 6, fr = lane & 15, fq = lane >> 4;
    LAS bf16_t* K_s = (LAS bf16_t*)lds;
    LAS bf16_t* Vt_s = (LAS bf16_t*)(lds + 27648);
    const bf16_t* Z = (const bf16_t*)(p.ws + WS_Z);
    bf16_t* CAT = (bf16_t*)(p.ws + WS_CAT);
    for (int ai = ai0; ai < 576; ai += aistride) {
        const bool samp = ai >= 512;
        int b, c, g, nkeys, ntt, row0, krow0, nkc;
        if (!samp) { g = ai & 1; c = (ai >> 1) & 31; b = ai >> 6; nkc = (c < 2 ? c : 2) + 1; nkeys = 64 * nkc; ntt = 4; row0 = b * 2048 + c * 64; krow0 = row0 - (nkc - 1) * 64; }
        else { const int s = ai - 512; g = s & 1; b = s >> 1; c = 0; nkc = 0; nkeys = 160; ntt = 1; row0 = MP + b * 16; krow0 = 0; }
        for (int q = tid; q < nkeys * 8; q += 512) {
            const int key = q >> 3, d0 = (q & 7) * 8;
            float kf[8], vf[8]; bool donorm = false;
            if (!samp || (key >= 128 && key < 144)) {
                const int row = samp ? row0 + key - 128 : krow0 + key;
                const bf16x8 kr = *(const bf16x8*)(Z + (size_t)row * NZ + ZC_AK + g * 64 + d0), vr = *(const bf16x8*)(Z + (size_t)row * NZ + ZC_AV + g * 64 + d0);
#pragma unroll
                for (int e = 0; e < 8; ++e) { kf[e] = bf2f(kr[e]); vf[e] = bf2f(vr[e]); }
                donorm = true;
            } else if (key < 128) {
                const size_t o = ((size_t)(b * 128 + key) * 2 + g) * 64 + d0;
                const float4 k0 = *(const float4*)(p.in[2] + o), k1 = *(const float4*)(p.in[2] + o + 4), v0 = *(const float4*)(p.in[3] + o), v1 = *(const float4*)(p.in[3] + o + 4);
                kf[0] = k0.x; kf[1] = k0.y; kf[2] = k0.z; kf[3] = k0.w; kf[4] = k1.x; kf[5] = k1.y; kf[6] = k1.z; kf[7] = k1.w;
                vf[0] = v0.x; vf[1] = v0.y; vf[2] = v0.z; vf[3] = v0.w; vf[4] = v1.x; vf[5] = v1.y; vf[6] = v1.z; vf[7] = v1.w;
            } else {
#pragma unroll
                for (int e = 0; e < 8; ++e) { kf[e] = 0.f; vf[e] = 0.f; }
            }
            float ss = 0.f;
#pragma unroll
            for (int e = 0; e < 8; ++e) ss += kf[e] * kf[e];
            ss = sum8(ss);
            if (donorm) { const float r = rsqrtf(ss * (1.0f / 64.0f) + 1e-6f);
                const float4 n0 = *(const float4*)(p.in[10] + d0), n1 = *(const float4*)(p.in[10] + d0 + 4);
                kf[0] *= r * n0.x; kf[1] *= r * n0.y; kf[2] *= r * n0.z; kf[3] *= r * n0.w; kf[4] *= r * n1.x; kf[5] *= r * n1.y; kf[6] *= r * n1.z; kf[7] *= r * n1.w; }
            u32x4 w; w.x = cvt_pk_bf16(kf[0], kf[1]); w.y = cvt_pk_bf16(kf[2], kf[3]); w.z = cvt_pk_bf16(kf[4], kf[5]); w.w = cvt_pk_bf16(kf[6], kf[7]);
            *(LAS u32x4*)(K_s + key * 72 + d0) = w;
#pragma unroll
            for (int e = 0; e < 8; ++e) Vt_s[(d0 + e) * 200 + key] = f2bf(vf[e]);
            float* ok = nullptr; float* ov = nullptr;
            if (!samp) { if (c >= 30 && key >= nkeys - 64) { const int t = c * 64 + (key - (nkeys - 64)) - 1920; const size_t o = ((size_t)(b * 128 + t) * 2 + g) * 64 + d0; ok = p.out + O_PAK + o; ov = p.out + O_PAV + o; } }
            else if (key >= 128 && key < 144) { const size_t o = ((size_t)(b * 16 + key - 128) * 2 + g) * 64 + d0; ok = p.out + O_SAK + o; ov = p.out + O_SAV + o; }
            if (ok) { *(float4*)ok = make_float4(kf[0], kf[1], kf[2], kf[3]); *(float4*)(ok + 4) = make_float4(kf[4], kf[5], kf[6], kf[7]);
                      *(float4*)ov = make_float4(vf[0], vf[1], vf[2], vf[3]); *(float4*)(ov + 4) = make_float4(vf[4], vf[5], vf[6], vf[7]); }
        }
        lds_barrier();
        const int nqt = 4 * ntt, nkt = nkeys >> 4;
        for (int qq = 0; qq < 2; ++qq) {
            const int qt = wid * 2 + qq;
            if (qt < nqt) {
                const int r = qt / ntt, tok0 = 16 * (qt % ntt), hh = g * 4 + r;
                const size_t qrow = (size_t)(row0 + tok0 + fr);
                bf16x8 Qf[2];
                {
                    const bf16x8 r0 = *(const bf16x8*)(Z + qrow * NZ + ZC_AQ + hh * 64 + 8 * fq), r1 = *(const bf16x8*)(Z + qrow * NZ + ZC_AQ + hh * 64 + 32 + 8 * fq);
                    float q0[8], q1[8]; float ss = 0.f;
#pragma unroll
                    for (int e = 0; e < 8; ++e) { q0[e] = bf2f(r0[e]); q1[e] = bf2f(r1[e]); ss += q0[e] * q0[e] + q1[e] * q1[e]; }
                    ss += __shfl_xor(ss, 16); ss += __shfl_xor(ss, 32);
                    const float rq = rsqrtf(ss * (1.0f / 64.0f) + 1e-6f) * 0.125f;
                    const float4 na = *(const float4*)(p.in[9] + 8 * fq), nb = *(const float4*)(p.in[9] + 8 * fq + 4), nc = *(const float4*)(p.in[9] + 32 + 8 * fq), nd = *(const float4*)(p.in[9] + 32 + 8 * fq + 4);
                    u32x4 w0, w1;
                    w0.x = cvt_pk_bf16(q0[0] * rq * na.x, q0[1] * rq * na.y); w0.y = cvt_pk_bf16(q0[2] * rq * na.z, q0[3] * rq * na.w);
                    w0.z = cvt_pk_bf16(q0[4] * rq * nb.x, q0[5] * rq * nb.y); w0.w = cvt_pk_bf16(q0[6] * rq * nb.z, q0[7] * rq * nb.w);
                    w1.x = cvt_pk_bf16(q1[0] * rq * nc.x, q1[1] * rq * nc.y); w1.y = cvt_pk_bf16(q1[2] * rq * nc.z, q1[3] * rq * nc.w);
                    w1.z = cvt_pk_bf16(q1[4] * rq * nd.x, q1[5] * rq * nd.y); w1.w = cvt_pk_bf16(q1[6] * rq * nd.z, q1[7] * rq * nd.w);
                    Qf[0] = __builtin_bit_cast(bf16x8, w0); Qf[1] = __builtin_bit_cast(bf16x8, w1);
                }
                const float slope = exp2f(-(float)(hh + 1));
                const float sink = p.in[11][hh];
                const int qoff = samp ? (tok0 + fr + 128) : ((nkc - 1) * 64 + tok0 + fr);
                f32x4 s[12]; float mx = sink;
#pragma unroll
                for (int kt = 0; kt < 12; ++kt) {
                    if (kt < nkt) {
                        f32x4 acc = {0.f, 0.f, 0.f, 0.f};
#pragma unroll
                        for (int kk = 0; kk < 2; ++kk) { const bf16x8 a = *(const LAS bf16x8*)(K_s + (16 * kt + fr) * 72 + 32 * kk + 8 * fq); acc = mfma16(a, Qf[kk], acc); }
#pragma unroll
                        for (int jj = 0; jj < 4; ++jj) { const int key = 16 * kt + 4 * fq + jj; const bool valid = !samp || key < 144;
                            const float sv = valid ? acc[jj] - slope * fabsf((float)(qoff - key)) : -1e30f; s[kt][jj] = sv; mx = fmaxf(mx, sv); }
                    } else { s[kt] = (f32x4){-1e30f, -1e30f, -1e30f, -1e30f}; }
                }
                mx = fmaxf(mx, __shfl_xor(mx, 16)); mx = fmaxf(mx, __shfl_xor(mx, 32));
                float l = 0.f;
#pragma unroll
                for (int kt = 0; kt < 12; ++kt)
#pragma unroll
                    for (int jj = 0; jj < 4; ++jj) { const float pv = __expf(s[kt][jj] - mx); s[kt][jj] = pv; l += pv; }
                l += __shfl_xor(l, 16); l += __shfl_xor(l, 32);
                l += __expf(sink - mx);
                const float inv = __builtin_amdgcn_rcpf(l);
                f32x4 o[4];
#pragma unroll
                for (int dt = 0; dt < 4; ++dt) o[dt] = (f32x4){0.f, 0.f, 0.f, 0.f};
#pragma unroll
                for (int u = 0; u < 6; ++u) {
                    if (2 * u < nkt) {
                        const bf16x8 Pf = pack8(s[2 * u], s[2 * u + 1]);
#pragma unroll
                        for (int dt = 0; dt < 4; ++dt) {
                            const u32x2 lo = *(const LAS u32x2*)(Vt_s + (16 * dt + fr) * 200 + 32 * u + 4 * fq), hi = *(const LAS u32x2*)(Vt_s + (16 * dt + fr) * 200 + 32 * u + 16 + 4 * fq);
                            o[dt] = mfma16(cat8(lo, hi), Pf, o[dt]);
                        }
                    }
                }
#pragma unroll
                for (int dt = 0; dt < 4; ++dt) {
                    const int d = 16 * dt + 4 * fq;
                    const bf16x4 ag = *(const bf16x4*)(Z + qrow * NZ + ZC_AG + hh * 64 + d);
                    u32x2 w; w.x = cvt_pk_bf16(o[dt][0] * inv * silu_f(bf2f(ag[0])), o[dt][1] * inv * silu_f(bf2f(ag[1])));
                    w.y = cvt_pk_bf16(o[dt][2] * inv * silu_f(bf2f(ag[2])), o[dt][3] * inv * silu_f(bf2f(ag[3])));
                    *(u32x2*)(CAT + qrow * DM + hh * 64 + d) = w;
                }
            }
        }
        lds_barrier();
    }
}

constexpr int SC_W = 0, SC_QS = 17408, SC_KT = 34816, SC_QK = 53248, SC_BUF = 62464;
template <bool PROMPT>
__device__ __forceinline__ void scan_block(const Params& p, LAS unsigned char* lds, int chs0, int nsteps, const float* s0, float* sfin, int rowbase, int ntok, int h, int half) {
    const int tid = threadIdx.x, lane = tid & 63, wid = tid >> 6, fr = lane & 15, fq = lane >> 4, slice = half * 4 + (wid & 3), dv = slice * 16 + fr;
    const bool comp = wid < 4;
    const unsigned char* dn = (const unsigned char*)p.out;
#define SC_BAR() do { asm volatile("s_waitcnt lgkmcnt(0)" ::: "memory"); __builtin_amdgcn_s_barrier(); asm volatile("" ::: "memory"); } while (0)
    if (!comp) {
        const int t = tid - 256, wrow = t >> 4, wc = t & 15, krow = t >> 3, kc = t & 7;
        u32x4 A[14], Bq[14];
#define SC_LOAD(R, chs) do { \
            const bf16_t* W_ = (const bf16_t*)(dn + DN_W) + (size_t)(chs) * 8192; const bf16_t* Q_ = (const bf16_t*)(dn + DN_QS) + (size_t)(chs) * 8192; \
            const bf16_t* K_ = (const bf16_t*)(dn + DN_KT) + (size_t)(chs) * 8192; const bf16_t* X_ = (const bf16_t*)(dn + DN_QK) + (size_t)(chs) * 4096; \
            _Pragma("unroll") for (int i_ = 0; i_ < 4; ++i_) { R[i_] = *(const u32x4*)(W_ + (wrow + 16 * i_) * 128 + wc * 8); R[4 + i_] = *(const u32x4*)(Q_ + (wrow + 16 * i_) * 128 + wc * 8); \
                R[8 + i_] = *(const u32x4*)(K_ + (krow + 32 * i_) * 64 + kc * 8); } \
            _Pragma("unroll") for (int i_ = 0; i_ < 2; ++i_) R[12 + i_] = *(const u32x4*)(X_ + (krow + 32 * i_) * 64 + kc * 8); } while (0)
#define SC_STORE(R, buf) do { LAS unsigned char* B_ = lds + (buf) * SC_BUF; \
            _Pragma("unroll") for (int i_ = 0; i_ < 4; ++i_) { *(LAS u32x4*)(B_ + SC_W + (wrow + 16 * i_) * 272 + wc * 16) = R[i_]; *(LAS u32x4*)(B_ + SC_QS + (wrow + 16 * i_) * 272 + wc * 16) = R[4 + i_]; \
                *(LAS u32x4*)(B_ + SC_KT + (krow + 32 * i_) * 144 + kc * 16) = R[8 + i_]; } \
            _Pragma("unroll") for (int i_ = 0; i_ < 2; ++i_) *(LAS u32x4*)(B_ + SC_QK + (krow + 32 * i_) * 144 + kc * 16) = R[12 + i_]; } while (0)
        SC_LOAD(A, chs0);
        SC_STORE(A, 0);
        SC_BAR();
        if constexpr (PROMPT) {
            SC_LOAD(A, chs0 + 1); SC_LOAD(Bq, chs0 + 2);
            for (int n = 0; n < nsteps; n += 2) {
                SC_STORE(A, 1);  { const int c = (n + 3 < nsteps) ? n + 3 : nsteps - 1; SC_LOAD(A, chs0 + c); }  SC_BAR();
                SC_STORE(Bq, 0); { const int c = (n + 4 < nsteps) ? n + 4 : nsteps - 1; SC_LOAD(Bq, chs0 + c); } SC_BAR();
            }
        } else {
            SC_BAR();
        }
#undef SC_LOAD
#undef SC_STORE
        return;
    }
    bf16_t* CAT = (bf16_t*)(p.ws + WS_CAT);
    f32x4 ST[8];
#pragma unroll
    for (int T = 0; T < 8; ++T)
#pragma unroll
        for (int jj = 0; jj < 4; ++jj) ST[T][jj] = s0 ? s0[(size_t)(16 * T + 4 * fq + jj) * 128 + dv] : 0.f;
    bf16x4 u4n[4]; f32x4 g4n[4]; float Gln;
#define SC_UG(chs) do { const bf16_t* U_ = (const bf16_t*)(p.ws + WS_UT) + (size_t)(chs) * 8192; const float* G_ = (const float*)(p.ws + WS_GB) + (size_t)(chs) * 64; \
        _Pragma("unroll") for (int tt = 0; tt < 4; ++tt) { u4n[tt] = *(const bf16x4*)(U_ + dv * 64 + 16 * tt + 4 * fq); g4n[tt] = *(const f32x4*)(G_ + 16 * tt + 4 * fq); } \
        Gln = G_[63]; } while (0)
    SC_UG(chs0);
    SC_BAR();
    for (int n = 0; n < nsteps; ++n) {
        bf16x4 u4[4]; f32x4 g4[4]; const float Glc = Gln;
#pragma unroll
        for (int tt = 0; tt < 4; ++tt) { u4[tt] = u4n[tt]; g4[tt] = g4n[tt]; }
        if constexpr (PROMPT) { const int c = (n + 1 < nsteps) ? n + 1 : nsteps - 1; SC_UG(chs0 + c); }
        __builtin_amdgcn_sched_barrier(0);
        const LAS unsigned char* B = lds + (n & 1) * SC_BUF;
        bf16x8 Sb[4];
#pragma unroll
        for (int P = 0; P < 4; ++P) Sb[P] = pack8(ST[2 * P], ST[2 * P + 1]);
        f32x4 ws[4], qs[4];
        bf16x8 fa[8];
#pragma unroll
        for (int tt = 0; tt < 4; ++tt) {
#pragma unroll
            for (int P = 0; P < 4; ++P) { fa[P] = *(const LAS bf16x8*)(B + SC_W + (16 * tt + fr) * 272 + (32 * P + 8 * fq) * 2);
                                          fa[4 + P] = *(const LAS bf16x8*)(B + SC_QS + (16 * tt + fr) * 272 + (32 * P + 8 * fq) * 2); }
            __builtin_amdgcn_sched_barrier(0);
            ws[tt] = (f32x4){0.f, 0.f, 0.f, 0.f}; qs[tt] = (f32x4){0.f, 0.f, 0.f, 0.f};
#pragma unroll
            for (int P = 0; P < 4; ++P) { ws[tt] = mfma16(fa[P], Sb[P], ws[tt]); qs[tt] = mfma16(fa[4 + P], Sb[P], qs[tt]); }
            __builtin_amdgcn_sched_barrier(0);
        }
        bf16x8 fq_[8], fk[8];
#pragma unroll
        for (int tt = 0; tt < 4; ++tt)
#pragma unroll
            for (int u = 0; u < 2; ++u) fq_[tt * 2 + u] = *(const LAS bf16x8*)(B + SC_QK + (16 * tt + fr) * 144 + (32 * u + 8 * fq) * 2);
        __builtin_amdgcn_sched_barrier(0);
        f32x4 vn[4], vd[4];
#pragma unroll
        for (int tt = 0; tt < 4; ++tt)
#pragma unroll
            for (int jj = 0; jj < 4; ++jj) { vn[tt][jj] = bf2f(u4[tt][jj]) - ws[tt][jj]; vd[tt][jj] = vn[tt][jj] * __expf(Glc - g4[tt][jj]); }
        bf16x8 Vb[2], Vd[2];
#pragma unroll
        for (int u = 0; u < 2; ++u) { Vb[u] = pack8(vn[2 * u], vn[2 * u + 1]); Vd[u] = pack8(vd[2 * u], vd[2 * u + 1]); }
        f32x4 o[4];
#pragma unroll
        for (int tt = 0; tt < 4; ++tt)
#pragma unroll
            for (int jj = 0; jj < 4; ++jj) o[tt][jj] = qs[tt][jj] * __expf(g4[tt][jj]);
        const float gt = __expf(Glc);
#pragma unroll
        for (int T = 0; T < 8; ++T) ST[T] = ST[T] * gt;
        __builtin_amdgcn_sched_barrier(0);
#pragma unroll
        for (int T = 0; T < 4; ++T)
#pragma unroll
            for (int u = 0; u < 2; ++u) fk[T * 2 + u] = *(const LAS bf16x8*)(B + SC_KT + (16 * T + fr) * 144 + (32 * u + 8 * fq) * 2);
        __builtin_amdgcn_sched_barrier(0);
#pragma unroll
        for (int tt = 0; tt < 4; ++tt)
#pragma unroll
            for (int u = 0; u < 2; ++u) o[tt] = mfma16(fq_[tt * 2 + u], Vb[u], o[tt]);
        __builtin_amdgcn_sched_barrier(0);
#pragma unroll
        for (int T = 0; T < 4; ++T)
#pragma unroll
            for (int u = 0; u < 2; ++u) fq_[T * 2 + u] = *(const LAS bf16x8*)(B + SC_KT + (16 * (4 + T) + fr) * 144 + (32 * u + 8 * fq) * 2);
        __builtin_amdgcn_sched_barrier(0);
#pragma unroll
        for (int T = 0; T < 4; ++T)
#pragma unroll
            for (int u = 0; u < 2; ++u) ST[T] = mfma16(fk[T * 2 + u], Vd[u], ST[T]);
        __builtin_amdgcn_sched_barrier(0);
#pragma unroll
        for (int T = 0; T < 4; ++T)
#pragma unroll
            for (int u = 0; u < 2; ++u) ST[4 + T] = mfma16(fq_[T * 2 + u], Vd[u], ST[4 + T]);
#pragma unroll
        for (int tt = 0; tt < 4; ++tt)
#pragma unroll
            for (int jj = 0; jj < 4; ++jj) {
                const int tok = 16 * tt + 4 * fq + jj;
                if constexpr (PROMPT) {
                    const unsigned row = (unsigned)(rowbase + n * 64 + tok);
                    CAT[row * (unsigned)DM + (unsigned)(512 + h * 128 + dv)] = f2bf(o[tt][jj]);
                } else {
                    const unsigned row = (unsigned)(rowbase + n * 64 + (tok < ntok ? tok : 0));
                    if (tok < ntok) CAT[row * (unsigned)DM + (unsigned)(512 + h * 128 + dv)] = f2bf(o[tt][jj]);
                }
            }
        SC_BAR();
    }
#undef SC_UG
#undef SC_BAR
#pragma unroll
    for (int T = 0; T < 8; ++T)
#pragma unroll
        for (int jj = 0; jj < 4; ++jj) sfin[(size_t)(16 * T + 4 * fq + jj) * 128 + dv] = ST[T][jj];
}

__device__ __forceinline__ void phase_scan(const Params& p, LAS unsigned char* lds) {
    if (blockIdx.x < 64) {
        const int pair = blockIdx.x >> 1, half = blockIdx.x & 1, b = pair >> 2, h = pair & 3;
        scan_block<true>(p, lds, pair * 32, 32, nullptr, p.out + O_PBS + (size_t)pair * 16384, b * 2048, 64, h, half);
    } else {
        const int bi = blockIdx.x - 64, nb = gridDim.x - 64;
        for (int s2 = bi; s2 < 256; s2 += nb) { const int s = s2 >> 1, half = s2 & 1, b = s >> 2, h = s & 3;
            scan_block<false>(p, lds, 1024 + s, 1, p.in[4] + (size_t)s * 16384, p.out + O_SBS + (size_t)s * 16384, MP + b * 16, 16, h, half); }
        attn_items(p, lds, bi, nb);
        { pg8::StaticOrder S; pg8::Gemm g{(const bf16_t*)(p.ws + WS_XN), (const bf16_t*)(p.ws + WS_WT_IN) + (size_t)ZC_BG * 1024, MTOK, 512, 1024, 1024, 0}; S.init(MTOK, 512, nb, bi);
          pg8::EpiZ E{(bf16_t*)(p.ws + WS_Z) + ZC_BG, NZ}; pg8::gemm_phase(lds, g, S, E); }
    }
}

__device__ __forceinline__ void phase_onorm(const Params& p) {
    const bf16_t* Z = (const bf16_t*)(p.ws + WS_Z);
    bf16_t* CAT = (bf16_t*)(p.ws + WS_CAT);
    const int nthr = gridDim.x * 512, total = MTOK * 64;
    const int c8 = (threadIdx.x & 63) * 8, d = c8 & 127;
    const float4 n0 = *(const float4*)(p.in[15] + d), n1 = *(const float4*)(p.in[15] + d + 4);
    const float nn[8] = {n0.x, n0.y, n0.z, n0.w, n1.x, n1.y, n1.z, n1.w};
    for (int idx = blockIdx.x * 512 + threadIdx.x; idx < total; idx += 8 * nthr) {
        bf16x8 ov[8], gv[8];
#pragma unroll
        for (int q = 0; q < 8; ++q) { const int id = idx + q * nthr; const int row = (id < total ? id : idx) >> 6;
            ov[q] = *(const bf16x8*)(CAT + (size_t)row * DM + 512 + c8); gv[q] = *(const bf16x8*)(Z + (size_t)row * NZ + ZC_BG + c8); }
#pragma unroll
        for (int q = 0; q < 8; ++q) {
            const int id = idx + q * nthr;
            float y[8]; float ss = 0.f;
#pragma unroll
            for (int e = 0; e < 8; ++e) { y[e] = bf2f(ov[q][e]); ss += y[e] * y[e]; }
            ss = sum16(ss);
            const float r = rsqrtf(ss * (1.0f / 128.0f) + 1e-6f);
#pragma unroll
            for (int e = 0; e < 8; ++e) y[e] = y[e] * r * nn[e] * silu_f(bf2f(gv[q][e]));
            u32x4 w; w.x = cvt_pk_bf16(y[0], y[1]); w.y = cvt_pk_bf16(y[2], y[3]); w.z = cvt_pk_bf16(y[4], y[5]); w.w = cvt_pk_bf16(y[6], y[7]);
            if (id < total) *(u32x4*)(CAT + (size_t)(id >> 6) * DM + 512 + c8) = w;
        }
    }
}

template <int W>
__device__ __forceinline__ void pool_item(const Params& p, const bf16_t* __restrict__ U, bf16_t* __restrict__ PO, bool samp, int b, int rowb, int t0, int c4) {
    constexpr int NR = 8;
    const float* hist = p.in[6] + (size_t)b * 15 * 1024;
    f32x4 r[W + NR - 1];
#pragma unroll
    for (int j = 0; j < W + NR - 1; ++j) {
        const int tp = t0 - W + 1 + j;
        if (tp >= 0) { const bf16x4 v = *(const bf16x4*)(U + (size_t)(rowb + tp) * DM + c4); r[j] = (f32x4){bf2f(v[0]), bf2f(v[1]), bf2f(v[2]), bf2f(v[3])}; }
        else if (samp) r[j] = *(const f32x4*)(hist + (size_t)(15 + tp) * 1024 + c4);
        else r[j] = (f32x4){0.f, 0.f, 0.f, 0.f};
    }
    f32x4 s = r[0];
#pragma unroll
    for (int j = 1; j < W; ++j) s += r[j];
#pragma unroll
    for (int k = 0; k < NR; ++k) {
        const int t = t0 + k;
        if (k > 0) s += r[k + W - 1] - r[k - 1];
        const f32x4 v = r[k + W - 1];
        const int cnt = samp ? W : ((t + 1) < W ? (t + 1) : W);
        const float ic = 1.0f / (float)cnt;
        u32x2 o; o.x = cvt_pk_bf16(s[0] * ic - v[0], s[1] * ic - v[1]); o.y = cvt_pk_bf16(s[2] * ic - v[2], s[3] * ic - v[3]);
        *(u32x2*)(PO + (size_t)(rowb + t) * DM + c4) = o;
        if (!samp) { if (t >= 2033) *(f32x4*)(p.out + O_PCP + ((size_t)b * 15 + (t - 2033)) * 1024 + c4) = v; }
        else if (t >= 1) *(f32x4*)(p.out + O_SCP + ((size_t)b * 15 + (t - 1)) * 1024 + c4) = v;
    }
}
__device__ __forceinline__ void phase_pool(const Params& p) {
    const bf16_t* U = (const bf16_t*)(p.ws + WS_U);
    bf16_t* PO = (bf16_t*)(p.ws + WS_POOL);
    const int nthr = gridDim.x * 512;
    for (int idx = blockIdx.x * 512 + threadIdx.x; idx < 2112 * 256; idx += nthr) {
        const int c4 = (idx & 255) * 4, rg = idx >> 8;
        const bool samp = rg >= 2048;
        int b, rowb, t0;
        if (!samp) { b = rg >> 8; rowb = b * 2048; t0 = (rg & 255) * 8; } else { const int s = rg - 2048; b = s >> 1; rowb = MP + b * 16; t0 = (s & 1) * 8; }
        const int g = c4 >> 8;
        if (g == 0) pool_item<2>(p, U, PO, samp, b, rowb, t0, c4);
        else if (g == 1) pool_item<4>(p, U, PO, samp, b, rowb, t0, c4);
        else if (g == 2) pool_item<8>(p, U, PO, samp, b, rowb, t0, c4);
        else pool_item<16>(p, U, PO, samp, b, rowb, t0, c4);
    }
}

template <bool NORM> struct SEpiRes {
    const float* base; float* out; bf16_t* a3; const float* gvec; float* rowss;
    __device__ __forceinline__ void operator()(int row, int col, const f32x4& acc) const {
        if constexpr (NORM) { const f32x4 bv = *(const f32x4*)(base + (size_t)row * DM + col); const f32x4 v = acc + bv;
            float ss = (v[0] * v[0] + v[1] * v[1]) + (v[2] * v[2] + v[3] * v[3]);
            u32x2 w; w.x = cvt_pk_bf16(v[0], v[1]); w.y = cvt_pk_bf16(v[2], v[3]); *(u32x2*)(a3 + (size_t)row * DM + col) = w;
            ss += __shfl_xor(ss, 16); ss += __shfl_xor(ss, 32); if ((threadIdx.x & 48) == 0) atomicAdd(rowss + row, ss);
        } else { const bf16x4 hb = *(const bf16x4*)(a3 + (size_t)row * DM + col);
            *(f32x4*)(out + (size_t)row * DM + col) = acc + (f32x4){bf2f(hb[0]), bf2f(hb[1]), bf2f(hb[2]), bf2f(hb[3])}; } }
};
struct SEpiUG {
    bf16_t* U; bf16_t* SG; const float* rowss;
    __device__ __forceinline__ void operator()(int row, int col, const f32x4& acc) const {
        const f32x4 v = acc * rsqrtf(rowss[row] * (1.0f / 1024.0f) + 1e-6f);
        if (col < 1024) { u32x2 w; w.x = cvt_pk_bf16(v[0], v[1]); w.y = cvt_pk_bf16(v[2], v[3]); *(u32x2*)(U + (size_t)row * DM + col) = w; }
        else { u32x2 w; w.x = cvt_pk_bf16(silu_f(v[0]), silu_f(v[1])); w.y = cvt_pk_bf16(silu_f(v[2]), silu_f(v[3])); *(u32x2*)(SG + (size_t)row * DM + col - 1024) = w; } }
};
struct SEpiM {
    const float* scale; const bf16_t* SG; bf16_t* O;
    __device__ __forceinline__ void operator()(int row, int col, const f32x4& v) const {
        const f32x4 sc = *(const f32x4*)(scale + col); const bf16x4 gv = *(const bf16x4*)(SG + (size_t)row * DM + col);
        u32x2 w; w.x = cvt_pk_bf16(v[0] * sc[0] * bf2f(gv[0]), v[1] * sc[1] * bf2f(gv[1])); w.y = cvt_pk_bf16(v[2] * sc[2] * bf2f(gv[2]), v[3] * sc[3] * bf2f(gv[3]));
        *(u32x2*)(O + (size_t)row * DM + col) = w; }
};
template <int KS, class Epi>
__device__ __forceinline__ void small_gemm(const bf16_t* __restrict__ A, int lda, int a_grp_step, const bf16_t* __restrict__ Bt, int N, const Epi& E, LAS unsigned char* lds) {
    constexpr int K = KS * 128;
    const int lane = threadIdx.x & 63, wid = threadIdx.x >> 6, fr = lane & 15, fq = lane >> 4, th = wid >> 2, kq = wid & 3;
    LAS f32x4* red = (LAS f32x4*)lds;
    const int ntile = 16 * (N >> 5);
    for (int pair = blockIdx.x; pair * 2 < ntile; pair += gridDim.x) {
        const int tile = pair * 2 + th, tr = tile & 15, tc = tile >> 4, row0 = MP + tr * 32, col0 = tc * 32;
        const bf16_t* ap = A + (size_t)(row0 + fr) * lda + (col0 >> 8) * a_grp_step + kq * (KS * 32) + 8 * fq;
        const bf16_t* bp = Bt + (size_t)(col0 + fr) * K + kq * (KS * 32) + 8 * fq;
        bf16x8 a[KS][2], b[KS][2];
#pragma unroll
        for (int k = 0; k < KS; ++k)
#pragma unroll
            for (int m = 0; m < 2; ++m) { a[k][m] = *(const bf16x8*)(ap + (size_t)(16 * m) * lda + 32 * k); b[k][m] = *(const bf16x8*)(bp + (size_t)(16 * m) * K + 32 * k); }
        f32x4 acc[2][2];
#pragma unroll
        for (int mi = 0; mi < 2; ++mi)
#pragma unroll
            for (int ni = 0; ni < 2; ++ni) acc[mi][ni] = (f32x4){0.f, 0.f, 0.f, 0.f};
#pragma unroll
        for (int k = 0; k < KS; ++k)
#pragma unroll
            for (int mi = 0; mi < 2; ++mi)
#pragma unroll
                for (int ni = 0; ni < 2; ++ni) acc[mi][ni] = mfma16(b[k][ni], a[k][mi], acc[mi][ni]);
#pragma unroll
        for (int mi = 0; mi < 2; ++mi)
#pragma unroll
            for (int ni = 0; ni < 2; ++ni) red[(wid * 4 + mi * 2 + ni) * 64 + lane] = acc[mi][ni];
        lds_barrier();
        {
            const int sub = kq, mi = sub >> 1, ni = sub & 1;
            f32x4 s = red[((th * 4 + 0) * 4 + sub) * 64 + lane];
#pragma unroll
            for (int q = 1; q < 4; ++q) s += red[((th * 4 + q) * 4 + sub) * 64 + lane];
            E(row0 + 16 * mi + fr, col0 + 16 * ni + 4 * fq, s);
        }
        lds_barrier();
    }
}

#define XB_TMO      128
#define XB_XCNT(j)  (256  + 64 * (j))
#define XB_XSUB(j)  (1280 + 64 * (j))
#define XB_XGEN(j)  (2304 + 64 * (j))
#define XB_TOP      3328
#define XB_TOPGEN   3392
#define XCD_BAR_WORDS 3456
#define XB_SPIN_CAP (1u << 18)
__device__ __forceinline__ unsigned xb_ld(unsigned* p)              { return __hip_atomic_load(p, __ATOMIC_RELAXED, __HIP_MEMORY_SCOPE_AGENT); }
__device__ __forceinline__ unsigned xb_add(unsigned* p, unsigned v) { return __hip_atomic_fetch_add(p, v, __ATOMIC_RELAXED, __HIP_MEMORY_SCOPE_AGENT); }
__device__ __forceinline__ unsigned xb_xcc_id() { return (unsigned)__builtin_amdgcn_s_getreg((3 << 11) | 20) & 0xFu; }
#define XB_SPIN(cond, bar) do { unsigned _sp = 0; while (cond) { __builtin_amdgcn_s_sleep(1); \
    if ((++_sp & 255u) == 0u) { if (xb_ld(&(bar)[XB_TMO])) break; if (_sp > XB_SPIN_CAP) { atomicAdd(&(bar)[XB_TMO], 1u); break; } } } } while (0)
struct XcdBarrier { unsigned* bar; unsigned x; volatile LAS unsigned* st; };
__device__ __forceinline__ XcdBarrier xcd_barrier_post(unsigned* bar, volatile LAS unsigned* st) {
    XcdBarrier b; b.bar = bar; b.x = xb_xcc_id(); b.st = st;
    if (threadIdx.x == 0) (void)xb_add(&bar[XB_XCNT(b.x)], 1u);
    return b;
}
__device__ __forceinline__ void xcd_barrier_complete(unsigned* bar, unsigned x, unsigned& nloc, unsigned& nx) {
    const unsigned G = gridDim.x * gridDim.y * gridDim.z;
    unsigned sum, cnt, mine, sp = 0u;
    for (;;) {
        sum = 0u; cnt = 0u; mine = 0u;
#pragma unroll
        for (unsigned j = 0; j < 16; ++j) { const unsigned c = xb_ld(&bar[XB_XCNT(j)]); sum += c; cnt += (c > 0u) ? 1u : 0u; mine = (j == x) ? c : mine; }
        if (sum == G) break;
        __builtin_amdgcn_s_sleep(1);
        if ((++sp & 255u) == 0u) { if (xb_ld(&bar[XB_TMO])) break; if (sp > XB_SPIN_CAP) { atomicAdd(&bar[XB_TMO], 1u); break; } }
    }
    nloc = mine > 0u ? mine : 1u; nx = cnt > 0u ? cnt : 1u;
}
__device__ __forceinline__ void xcd_barrier(const XcdBarrier& b) {
    asm volatile("s_waitcnt vmcnt(0)" ::: "memory");
    __syncthreads();
    if (threadIdx.x == 0) {
        unsigned* bar = b.bar;
        __builtin_amdgcn_s_waitcnt(0);
        unsigned nloc = b.st[0], nx = b.st[1];
        if (nloc == 0u) { xcd_barrier_complete(bar, b.x, nloc, nx); b.st[0] = nloc; b.st[1] = nx; }
        const unsigned old = xb_add(&bar[XB_XSUB(b.x)], 1u);
        const unsigned gen = old / nloc;
        if (old + 1u == (gen + 1u) * nloc) {
            __builtin_amdgcn_fence(__ATOMIC_RELEASE, "agent");
            asm volatile("s_waitcnt vmcnt(0)" ::: "memory");
            const unsigned og = xb_add(&bar[XB_TOP], 1u);
            const unsigned tg = og / nx;
            if (og + 1u == (tg + 1u) * nx) xb_add(&bar[XB_TOPGEN], 1u);
            else XB_SPIN(xb_ld(&bar[XB_TOPGEN]) == tg, bar);
            __builtin_amdgcn_fence(__ATOMIC_ACQUIRE, "agent");
            xb_add(&bar[XB_XGEN(b.x)], 1u);
            asm volatile("s_waitcnt vmcnt(0)" ::: "memory");
        } else {
            XB_SPIN(xb_ld(&bar[XB_XGEN(b.x)]) == gen, bar);
            __builtin_amdgcn_fence(__ATOMIC_ACQUIRE, "agent");
            asm volatile("s_waitcnt vmcnt(0)" ::: "memory");
        }
    }
    __syncthreads();
}

constexpr int NPHASE = 11;
#ifndef PHMASK
#define PHMASK 0x7ff
#endif
#define PH_ON(k) (((PHMASK >> (k)) & 1) && p.ph_lo <= (k) && (k) < p.ph_hi)
#define PH_SYNC(k) do { if (p.ph_lo < (k) && (k) < p.ph_hi) xcd_barrier(xb); } while (0)
#ifndef MK_REP
#define MK_REP 0
#endif
#define PH_REP(k) (((MK_REP >> (k)) & 1) ? 2 : 1)
__global__ void __launch_bounds__(512, 2) mega(Params p) {
    extern __shared__ __attribute__((aligned(16))) unsigned char lds[];
    cg::grid_group grid = cg::this_grid();
    unsigned char* ws = p.ws;
    LAS unsigned char* L = (LAS unsigned char*)lds;
    if (p.ph_hi > NPHASE) grid.sync();
    volatile LAS unsigned* xst = (volatile LAS unsigned*)(L + pg8::STAGE_BYTES);
    if (threadIdx.x == 0) { xst[0] = 0u; xst[1] = 0u; xst[2] = 0u; xst[3] = 0u; }
    __syncthreads();
    const XcdBarrier xb = xcd_barrier_post((unsigned*)(ws + WS_BAR), xst);
    if (PH_ON(0)) for (int rep = 0; rep < PH_REP(0); ++rep) phase_prep(p, L);
    PH_SYNC(1);
    if (PH_ON(1)) { pg8::StaticOrder S; pg8::Gemm g{(const bf16_t*)(ws + WS_XN), (const bf16_t*)(ws + WS_WT_IN), MTOK, 2816, 1024, 1024, 0}; S.init(MTOK, 2816, gridDim.x, blockIdx.x);
        pg8::EpiZ E{(bf16_t*)(ws + WS_Z), NZ}; pg8::gemm_phase((LAS unsigned char*)lds, g, S, E); }
    PH_SYNC(2);
    if (PH_ON(2)) dn_prep(p, L);
    PH_SYNC(3);
    if (PH_ON(3)) phase_scan(p, L);
    PH_SYNC(4);
    if (PH_ON(4)) phase_onorm(p);
    PH_SYNC(5);
    if (PH_ON(5)) { pg8::StaticOrder S; const bool sfirst = (blockIdx.x & 1) != 0;
        if (sfirst) { SEpiRes<true> SE{p.in[1] - (size_t)MP * DM, p.out, (bf16_t*)(ws + WS_XN), p.in[17], (float*)(ws + WS_ROWSS)}; small_gemm<8>((const bf16_t*)(ws + WS_CAT), 1024, 0, (const bf16_t*)(ws + WS_WT_OUT), 1024, SE, L); }
        pg8::Gemm g{(const bf16_t*)(ws + WS_CAT), (const bf16_t*)(ws + WS_WT_OUT), MP, 1024, 1024, 1024, 0}; S.init(MP, 1024, gridDim.x, blockIdx.x);
        pg8::EpiRes<true> E{p.in[0], p.in[1], p.out, (bf16_t*)(ws + WS_XN), p.in[17], (float*)(ws + WS_ROWSS)}; pg8::gemm_phase((LAS unsigned char*)lds, g, S, E);
        if (!sfirst) { SEpiRes<true> SE{p.in[1] - (size_t)MP * DM, p.out, (bf16_t*)(ws + WS_XN), p.in[17], (float*)(ws + WS_ROWSS)}; small_gemm<8>((const bf16_t*)(ws + WS_CAT), 1024, 0, (const bf16_t*)(ws + WS_WT_OUT), 1024, SE, L); } }
    PH_SYNC(7);
    if (PH_ON(7)) { pg8::StaticOrder S; const bool sfirst = (blockIdx.x & 1) != 0;
        if (sfirst) { SEpiUG SE{(bf16_t*)(ws + WS_U), (bf16_t*)(ws + WS_SG), (const float*)(ws + WS_ROWSS)}; small_gemm<8>((const bf16_t*)(ws + WS_XN), 1024, 0, (const bf16_t*)(ws + WS_WT_INC), 2048, SE, L); }
        pg8::Gemm g{(const bf16_t*)(ws + WS_XN), (const bf16_t*)(ws + WS_WT_INC), MP, 2048, 1024, 1024, 0}; S.init(MP, 2048, gridDim.x, blockIdx.x);
        pg8::EpiUG E{(bf16_t*)(ws + WS_U), (bf16_t*)(ws + WS_SG), (const float*)(ws + WS_ROWSS)}; pg8::gemm_phase((LAS unsigned char*)lds, g, S, E);
        if (!sfirst) { SEpiUG SE{(bf16_t*)(ws + WS_U), (bf16_t*)(ws + WS_SG), (const float*)(ws + WS_ROWSS)}; small_gemm<8>((const bf16_t*)(ws + WS_XN), 1024, 0, (const bf16_t*)(ws + WS_WT_INC), 2048, SE, L); } }
    PH_SYNC(8);
    if (PH_ON(8)) for (int rep = 0; rep < PH_REP(8); ++rep) phase_pool(p);
    PH_SYNC(9);
    if (PH_ON(9)) { pg8::StaticOrder S; { SEpiM SE{p.in[20], (const bf16_t*)(ws + WS_SG), (bf16_t*)(ws + WS_MM)}; small_gemm<2>((const bf16_t*)(ws + WS_POOL), 1024, 256, (const bf16_t*)(ws + WS_WT_GRP), 1024, SE, L); }
        pg8::Gemm g{(const bf16_t*)(ws + WS_POOL), (const bf16_t*)(ws + WS_WT_GRP), MP, 1024, 256, 1024, 512}; S.init(MP, 1024, gridDim.x, blockIdx.x);
        pg8::EpiM E{p.in[20], (const bf16_t*)(ws + WS_SG), (bf16_t*)(ws + WS_MM)}; pg8::gemm_phase((LAS unsigned char*)lds, g, S, E); }
    PH_SYNC(10);
    if (PH_ON(10)) { pg8::StaticOrder S; const bool sfirst = (blockIdx.x & 1) != 0;
        if (sfirst) { SEpiRes<false> SE{nullptr, p.out, (bf16_t*)(ws + WS_XN), nullptr, nullptr}; small_gemm<8>((const bf16_t*)(ws + WS_MM), 1024, 0, (const bf16_t*)(ws + WS_WT_OUTC), 1024, SE, L); }
        pg8::Gemm g{(const bf16_t*)(ws + WS_MM), (const bf16_t*)(ws + WS_WT_OUTC), MP, 1024, 1024, 1024, 0}; S.init(MP, 1024, gridDim.x, blockIdx.x);
        pg8::EpiRes<false> E{nullptr, nullptr, p.out, (bf16_t*)(ws + WS_XN), nullptr, nullptr}; pg8::gemm_phase((LAS unsigned char*)lds, g, S, E);
        if (!sfirst) { SEpiRes<false> SE{nullptr, p.out, (bf16_t*)(ws + WS_XN), nullptr, nullptr}; small_gemm<8>((const bf16_t*)(ws + WS_MM), 1024, 0, (const bf16_t*)(ws + WS_WT_OUTC), 1024, SE, L); } }
}

extern "C" void kernel_launch(void* const* d_in, const int* in_sizes, int n_in, void* d_out, int out_size, void* d_ws, size_t ws_size, hipStream_t stream) {
    constexpr int LDS_BYTES = pg8::STAGE_BYTES + 256;
    static int grid = 0;
    if (grid == 0) {
        if (n_in != 22 || ws_size < WS_END) { fprintf(stderr, "kernel_launch: unexpected n_in %d / ws_size %zu\n", n_in, ws_size); grid = -1; return; }
        int dev = 0, cus = 0, per_cu = 0;
        if (hipGetDevice(&dev) != hipSuccess || hipDeviceGetAttribute(&cus, hipDeviceAttributeMultiprocessorCount, dev) != hipSuccess) { grid = -1; return; }
        if (hipFuncSetAttribute((const void*)mega, hipFuncAttributeMaxDynamicSharedMemorySize, LDS_BYTES) != hipSuccess) { fprintf(stderr, "kernel_launch: hipFuncSetAttribute failed\n"); grid = -1; return; }
        if (hipOccupancyMaxActiveBlocksPerMultiprocessor(&per_cu, (const void*)mega, 512, LDS_BYTES) != hipSuccess || per_cu < 1) { fprintf(stderr, "kernel_launch: occupancy query says %d\n", per_cu); per_cu = 1; }
        (void)hipGetLastError();
        grid = cus;
    }
    if (grid < 0) return;
    if (hipMemsetAsync((char*)d_ws + WS_BAR, 0, XCD_BAR_WORDS * 4, stream) != hipSuccess) { fprintf(stderr, "kernel_launch: memset failed\n"); return; }
    Params p{};
    for (int i = 0; i < 22; ++i) p.in[i] = (const float*)d_in[i];
    p.out = (float*)d_out; p.ws = (unsigned char*)d_ws;
#if MK_LAUNCHES == 1
    p.ph_lo = 0; p.ph_hi = NPHASE;
    void* args[] = {&p};
    hipError_t e = hipLaunchCooperativeKernel((const void*)mega, dim3(grid), dim3(512), args, LDS_BYTES, stream);
    if (e != hipSuccess) fprintf(stderr, "cooperative launch failed: %s (grid %d)\n", hipGetErrorString(e), grid);
#else
    for (int ph = 0; ph < MK_STOP; ++ph) { p.ph_lo = ph; p.ph_hi = ph + 1; hipLaunchKernelGGL(mega, dim3(grid), dim3(512), LDS_BYTES, stream, p); }
#endif
}
```
